# Optimizing an MI355X kernel written in HIP

```python
import math
import jax, jax.numpy as jnp
from jax import lax
import numpy as np

D_MODEL = 1024
BATCH = 4
SEQ = 8192
DEPTH = 4

N_MIXERS = 2
N_HEADS = 4
QK_DIM = D_MODEL // (2 * N_HEADS)
V_DIM = D_MODEL // N_HEADS
CHUNK = 128
GATE_CAP = 15.0
CONV_WIDTH = 3
D_FF = 4 * D_MODEL
EPS = 1e-6
N_MLSTM_LAYERS = (DEPTH + 1) // 2
N_CONV_LAYERS = DEPTH // 2
QK_COLS = N_HEADS * QK_DIM
MLSTM_IN = 2 * QK_COLS + 2 * D_MODEL + 2 * N_HEADS
CONV_IN = 3 * D_MODEL

kernel_name = "hybrid_mlstm_shortconv_sqrelu"


def rms_norm(x, g):
    xf = x.astype(jnp.float32)
    y = xf * lax.rsqrt(jnp.mean(xf * xf, axis=-1, keepdims=True) + EPS)
    return (y * g.astype(jnp.float32)).astype(x.dtype)


def mlstm_mixer(x, w_in, b_gates, g_hnorm, w_out):
    B_, S, _ = x.shape
    nc = S // CHUNK
    proj = x @ w_in
    q, k, v, o, gates = jnp.split(
        proj, [QK_COLS, 2 * QK_COLS, 2 * QK_COLS + D_MODEL, 2 * QK_COLS + 2 * D_MODEL], axis=-1)
    f32 = jnp.float32
    q = q.astype(f32).reshape(B_, S, N_HEADS, QK_DIM).transpose(0, 2, 1, 3)
    k = (k.astype(f32) * (QK_DIM ** -0.5)).reshape(B_, S, N_HEADS, QK_DIM).transpose(0, 2, 1, 3)
    v = v.astype(f32).reshape(B_, S, N_HEADS, V_DIM).transpose(0, 2, 1, 3)
    gates = gates.astype(f32) + b_gates.astype(f32)
    gates = GATE_CAP * jnp.tanh(gates / GATE_CAP)
    ig = gates[..., :N_HEADS].transpose(0, 2, 1)
    logf = jax.nn.log_sigmoid(gates[..., N_HEADS:]).transpose(0, 2, 1)

    qc = q.reshape(B_, N_HEADS, nc, CHUNK, QK_DIM)
    kc = k.reshape(B_, N_HEADS, nc, CHUNK, QK_DIM)
    vc = v.reshape(B_, N_HEADS, nc, CHUNK, V_DIM)
    igc = ig.reshape(B_, N_HEADS, nc, CHUNK)
    bcum = jnp.cumsum(logf.reshape(B_, N_HEADS, nc, CHUNK), axis=-1)
    b_last = bcum[..., -1]

    log_w = b_last[..., None] - bcum + igc
    m_loc = jnp.max(log_w, axis=-1)
    w = jnp.exp(log_w - m_loc[..., None])
    kv_loc = jnp.einsum('bhcl,bhcld,bhcle->bhcde', w, kc, vc)
    n_loc = jnp.einsum('bhcl,bhcld->bhcd', w, kc)

    def step(carry, inp):
        C, n, m = carry
        bl, ml, kvl, nl = inp
        m_new = jnp.maximum(bl + m, ml)
        a = jnp.exp(bl + m - m_new)
        s = jnp.exp(ml - m_new)
        C_new = a[..., None, None] * C + s[..., None, None] * kvl
        n_new = a[..., None] * n + s[..., None] * nl
        return (C_new, n_new, m_new), (C, n, m)

    init = (jnp.zeros((B_, N_HEADS, QK_DIM, V_DIM), f32),
            jnp.zeros((B_, N_HEADS, QK_DIM), f32),
            jnp.zeros((B_, N_HEADS), f32))
    xs = (jnp.moveaxis(b_last, 2, 0), jnp.moveaxis(m_loc, 2, 0),
          jnp.moveaxis(kv_loc, 2, 0), jnp.moveaxis(n_loc, 2, 0))
    _, (C_prev, n_prev, m_prev) = lax.scan(step, init, xs)
    C_prev = jnp.moveaxis(C_prev, 0, 2)
    n_prev = jnp.moveaxis(n_prev, 0, 2)
    m_prev = jnp.moveaxis(m_prev, 0, 2)

    causal = jnp.tril(jnp.ones((CHUNK, CHUNK), dtype=bool))
    logD = bcum[..., :, None] - bcum[..., None, :] + igc[..., None, :]
    logD = jnp.where(causal, logD, -jnp.inf)
    log_inter = bcum + m_prev[..., None]
    m_t = jnp.maximum(jnp.max(logD, axis=-1), log_inter)
    Dm = jnp.exp(logD - m_t[..., None])
    scores = jnp.einsum('bhcld,bhcsd->bhcls', qc, kc) * Dm
    inter = jnp.exp(log_inter - m_t)
    num = (jnp.einsum('bhcls,bhcse->bhcle', scores, vc)
           + inter[..., None] * jnp.einsum('bhcld,bhcde->bhcle', qc, C_prev))
    den = jnp.sum(scores, axis=-1) + inter * jnp.einsum('bhcld,bhcd->bhcl', qc, n_prev)
    h = num / jnp.maximum(jnp.abs(den), jnp.exp(-m_t))[..., None]

    h = h.reshape(B_, N_HEADS, S, V_DIM).transpose(0, 2, 1, 3)
    h = h * lax.rsqrt(jnp.mean(h * h, axis=-1, keepdims=True) + EPS)
    h = h * g_hnorm.astype(f32).reshape(N_HEADS, V_DIM)
    h = jax.nn.sigmoid(o.astype(f32)) * h.reshape(B_, S, D_MODEL)
    return h.astype(x.dtype) @ w_out


def short_conv_mixer(x, w_in, w_conv, w_out):
    proj = x @ w_in
    bgate, cgate, xh = jnp.split(proj, 3, axis=-1)
    u = cgate * xh
    conv = lax.conv_general_dilated(
        u, w_conv[:, None, :].astype(u.dtype), window_strides=(1,),
        padding=[(CONV_WIDTH - 1, 0)],
        dimension_numbers=('NWC', 'WIO', 'NWC'),
        feature_group_count=D_MODEL)
    return (bgate * conv) @ w_out


def sqrelu_mlp(x, w_up, w_down):
    h = jax.nn.relu(x @ w_up)
    return (h * h) @ w_down


def setup_inputs(seed: int = 0) -> dict:
    key = jax.random.key(seed)
    ks = jax.random.split(key, 12)
    f32 = jnp.float32
    x = jax.random.normal(ks[0], (BATCH, SEQ, D_MODEL), f32)
    norm_g = 1.0 + 0.05 * jax.random.normal(ks[1], (DEPTH, 4, D_MODEL), f32)
    w_in_mlstm = jax.random.normal(ks[2], (N_MLSTM_LAYERS, D_MODEL, MLSTM_IN), f32) * D_MODEL ** -0.5
    i_bias = -3.0 + 0.1 * jax.random.normal(ks[3], (N_MLSTM_LAYERS, N_HEADS), f32)
    f_bias = (jnp.linspace(3.0, 6.0, N_HEADS, dtype=f32)[None, :]
              + 0.1 * jax.random.normal(ks[4], (N_MLSTM_LAYERS, N_HEADS), f32))
    b_gates_mlstm = jnp.concatenate([i_bias, f_bias], axis=-1)
    g_hnorm = 1.0 + 0.05 * jax.random.normal(ks[5], (N_MLSTM_LAYERS, D_MODEL), f32)
    w_out_mlstm = jax.random.normal(ks[6], (N_MLSTM_LAYERS, D_MODEL, D_MODEL), f32) * D_MODEL ** -0.5
    w_in_conv = jax.random.normal(ks[7], (N_CONV_LAYERS, D_MODEL, CONV_IN), f32) * D_MODEL ** -0.5
    w_conv = jax.random.normal(ks[8], (N_CONV_LAYERS, CONV_WIDTH, D_MODEL), f32) * CONV_WIDTH ** -0.5
    w_out_conv = jax.random.normal(ks[9], (N_CONV_LAYERS, D_MODEL, D_MODEL), f32) * D_MODEL ** -0.5
    w_mlp_up = jax.random.normal(ks[10], (DEPTH, D_MODEL, D_FF), f32) * D_MODEL ** -0.5
    w_mlp_down = jax.random.normal(ks[11], (DEPTH, D_FF, D_MODEL), f32) * D_FF ** -0.5
    return {"x": x, "norm_g": norm_g, "w_in_mlstm": w_in_mlstm, "b_gates_mlstm": b_gates_mlstm,
            "g_hnorm": g_hnorm, "w_out_mlstm": w_out_mlstm, "w_in_conv": w_in_conv,
            "w_conv": w_conv, "w_out_conv": w_out_conv, "w_mlp_up": w_mlp_up,
            "w_mlp_down": w_mlp_down}


def reference(x, norm_g, w_in_mlstm, b_gates_mlstm, g_hnorm, w_out_mlstm, w_in_conv,
              w_conv, w_out_conv, w_mlp_up, w_mlp_down):
    for i in range(DEPTH):
        g = norm_g[i]
        j = i // N_MIXERS
        h = rms_norm(x, g[0])
        if i % N_MIXERS == 0:
            h = mlstm_mixer(h, w_in_mlstm[j], b_gates_mlstm[j], g_hnorm[j], w_out_mlstm[j])
        else:
            h = short_conv_mixer(h, w_in_conv[j], w_conv[j], w_out_conv[j])
        x = x + rms_norm(h, g[1])
        h = sqrelu_mlp(rms_norm(x, g[2]), w_mlp_up[i], w_mlp_down[i])
        x = x + rms_norm(h, g[3])
    return x
```

```cpp
#include <hip/hip_runtime.h>
#include <cstdio>
#include <cstdint>
#include <cmath>
#ifndef MK_MULTI
#define MK_MULTI 1
#endif
namespace pg8 {
#define PG8_LAS __attribute__((address_space(3)))
typedef unsigned short bf16_t;
typedef short bf16x8 __attribute__((ext_vector_type(8)));
typedef float f32x4 __attribute__((ext_vector_type(4)));
typedef unsigned u32x4 __attribute__((ext_vector_type(4)));
constexpr int BM = 256, BK = 64, HALF = 128, HTB = HALF * BK * 2  , STAGE_BYTES = 8 * HTB, NXCD = 8, WGM = 8;

__host__ __device__ __forceinline__ int lds_byte(int r, int c) { const int st = (r >> 4) * 2 + (c >> 5), rr = r & 15, cc = c & 31, ob = rr * 64 + cc * 2; return st * 1024 + (ob ^ (((ob >> 9) & 1) << 5)); }
__host__ __device__ __forceinline__ void stage_rc(int b, int& R, int& C) { const int st = b / 1024, sb = b % 1024, swz = sb ^ (((sb >> 9) & 1) << 5); R = (st >> 1) * 16 + swz / 64; C = (st & 1) * 32 + (swz % 64) / 2; }
__host__ __device__ __forceinline__ int perm32(int rho) { const int n = rho >> 4, i = rho & 15; return 8 * (i >> 2) + 4 * n + (i & 3); }

struct Unit { int pm, pn; };
struct Gemm { const bf16_t* A; const bf16_t* Bt; int M, N, K; };

struct StaticOrder {
    int nM, nN, nwg, G, c;
    __host__ __device__ void init(int M, int N, int G_, int c_) { nM = M / BM; nN = N / BM; nwg = nM * nN; G = G_; c = c_; }
    __host__ __device__ bool next(int i, Unit& u) const {
        const long L = (long)i * G + c; if (L >= nwg) return false;
        int wgid = (int)L; { const int q = nwg / NXCD, r = nwg % NXCD, xcd = wgid % NXCD, off = wgid / NXCD; wgid = (xcd < r ? xcd * (q + 1) : r * (q + 1) + (xcd - r) * q) + off; }
        const int nig = WGM * nN, gid = wgid / nig, fm = gid * WGM, gsz = (nM - fm) < WGM ? (nM - fm) : WGM;
        u.pm = fm + ((wgid % nig) % gsz); u.pn = (wgid % nig) / gsz; return true;
    }
    __device__ __forceinline__ void a_ready(const Unit&) const {}
    __device__ __forceinline__ void done(const Unit&) const {}
};

__device__ __forceinline__ unsigned cvt_pk_bf16(float lo, float hi) { unsigned r; asm volatile("v_cvt_pk_bf16_f32 %0, %1, %2" : "=v"(r) : "v"(lo), "v"(hi)); return r; }
constexpr float RMS_EPS = 1e-6f;
__device__ __forceinline__ float rstd_row(const float* ssq, unsigned row) { const f32x4 s = *(const f32x4*)(ssq + row * 4u); return 1.0f / sqrtf(((s[0] + s[1]) + (s[2] + s[3])) * (1.0f / 1024.0f) + RMS_EPS); }
__device__ __forceinline__ u32x4 pack8(f32x4 v0, f32x4 v1) { u32x4 w; w.x = cvt_pk_bf16(v0[0], v0[1]); w.y = cvt_pk_bf16(v0[2], v0[3]); w.z = cvt_pk_bf16(v1[0], v1[1]); w.w = cvt_pk_bf16(v1[2], v1[3]); return w; }
__device__ __forceinline__ unsigned launder0() { unsigned z = 0u; asm volatile("" : "+v"(z)); return z; }
__device__ __forceinline__ float sigm(float x) { return 1.0f / (1.0f + __expf(-x)); }

struct EpiMlstmIn { static constexpr bool PERM = true, AFTER_DRAIN = false;
    bf16_t *q, *k, *v, *o; const float* ssq;
    __device__ __forceinline__ void operator()(const f32x4 (&acc)[2][2][4][2], const Unit& u, int wr, int wc, int fr, int fq) const {
        const int pn = u.pn; bf16_t* base; int ldc, colt; bool sig = false;
        if (pn < 2) { base = q; ldc = 512; colt = pn * 256; } else if (pn < 4) { base = k; ldc = 512; colt = (pn - 2) * 256; }
        else if (pn < 8) { base = v; ldc = 1024; colt = (pn - 4) * 256; } else { base = o; ldc = 1024; colt = (pn - 8) * 256; sig = true; }
        const unsigned row0 = u.pm * BM + wr * 64 + fr + launder0(), col0 = colt + wc * 32 + 8 * fq;
#pragma unroll
        for (int ai = 0; ai < 2; ++ai)
#pragma unroll
            for (int m = 0; m < 4; ++m) { const unsigned row = row0 + ai * HALF + m * 16; const float rs = rstd_row(ssq, row); bf16_t* rowp = base + (row * (unsigned)ldc + col0);
#pragma unroll
                for (int bj = 0; bj < 2; ++bj) { f32x4 v0 = acc[ai][bj][m][0] * rs, v1 = acc[ai][bj][m][1] * rs;
                    if (sig) {
#pragma unroll
                        for (int j = 0; j < 4; ++j) { v0[j] = sigm(v0[j]); v1[j] = sigm(v1[j]); } }
                    *(u32x4*)(rowp + bj * HALF) = pack8(v0, v1); } }
    }
};
struct EpiConvIn { static constexpr bool PERM = true, AFTER_DRAIN = false;
    bf16_t *ub, *bg; const float* ssq;
    __device__ __forceinline__ void operator()(const f32x4 (&acc)[2][2][4][2], const Unit& u, int wr, int wc, int fr, int fq) const {
        const int pn = u.pn; const unsigned row0 = u.pm * BM + wr * 64 + fr + launder0();
        if (pn < 8) { const unsigned col0 = pn * 128 + wc * 32 + 8 * fq;
#pragma unroll
            for (int ai = 0; ai < 2; ++ai)
#pragma unroll
                for (int m = 0; m < 4; ++m) { const unsigned row = row0 + ai * HALF + m * 16; const float rs = rstd_row(ssq, row), rs2 = rs * rs;
                    const f32x4 v0 = acc[ai][0][m][0] * acc[ai][1][m][0] * rs2, v1 = acc[ai][0][m][1] * acc[ai][1][m][1] * rs2;
                    *(u32x4*)(ub + (row * 1024u + col0)) = pack8(v0, v1); }
        } else { const unsigned col0 = (pn - 8) * 256 + wc * 32 + 8 * fq;
#pragma unroll
            for (int ai = 0; ai < 2; ++ai)
#pragma unroll
                for (int m = 0; m < 4; ++m) { const unsigned row = row0 + ai * HALF + m * 16; const float rs = rstd_row(ssq, row); bf16_t* rowp = bg + (row * 1024u + col0);
#pragma unroll
                    for (int bj = 0; bj < 2; ++bj) *(u32x4*)(rowp + bj * HALF) = pack8(acc[ai][bj][m][0] * rs, acc[ai][bj][m][1] * rs); }
        }
    }
};
struct EpiUp { static constexpr bool PERM = true, AFTER_DRAIN = false;
    bf16_t* hid; const float* ssq;
    __device__ __forceinline__ void operator()(const f32x4 (&acc)[2][2][4][2], const Unit& u, int wr, int wc, int fr, int fq) const {
        const unsigned row0 = u.pm * BM + wr * 64 + fr + launder0(), col0 = u.pn * BM + wc * 32 + 8 * fq;
#pragma unroll
        for (int ai = 0; ai < 2; ++ai)
#pragma unroll
            for (int m = 0; m < 4; ++m) { const unsigned row = row0 + ai * HALF + m * 16; const float rs = rstd_row(ssq, row); bf16_t* rowp = hid + (row * 4096u + col0);
#pragma unroll
                for (int bj = 0; bj < 2; ++bj) { f32x4 v0 = acc[ai][bj][m][0] * rs, v1 = acc[ai][bj][m][1] * rs;
#pragma unroll
                    for (int j = 0; j < 4; ++j) { const float a = fmaxf(v0[j], 0.f), b = fmaxf(v1[j], 0.f); v0[j] = a * a; v1[j] = b * b; }
                    *(u32x4*)(rowp + bj * HALF) = pack8(v0, v1); } }
    }
};
struct EpiF32P { static constexpr bool PERM = true, AFTER_DRAIN = false;
    float* C; int ldc;
    __device__ __forceinline__ void operator()(const f32x4 (&acc)[2][2][4][2], const Unit& u, int wr, int wc, int fr, int fq) const {
        const unsigned row0 = u.pm * BM + wr * 64 + fr + launder0(), col0 = u.pn * BM + wc * 32 + 8 * fq;
#pragma unroll
        for (int ai = 0; ai < 2; ++ai)
#pragma unroll
            for (int m = 0; m < 4; ++m) { float* rowp = C + ((row0 + ai * HALF + m * 16) * (unsigned)ldc + col0);
#pragma unroll
                for (int bj = 0; bj < 2; ++bj) { *(f32x4*)(rowp + bj * HALF) = acc[ai][bj][m][0]; *(f32x4*)(rowp + bj * HALF + 4) = acc[ai][bj][m][1]; } }
    }
};
template <class Epi, class Sched, bool ALIGN_EPI = false, bool SP2 = false>
__device__ __forceinline__ void gemm_phase(PG8_LAS unsigned char* lds, const Gemm g, const Sched& S, const Epi& E, const int tid_in) {
    const int tid = tid_in, wid = __builtin_amdgcn_readfirstlane(tid >> 6), lane = tid & 63, wr = wid >> 2, wc = wid & 3, fr = lane & 15, fq = lane >> 4;
    const int K = g.K, nt = K / BK;
    unsigned voffA[2], voffB[2];
#pragma unroll
    for (int i = 0; i < 2; ++i) { int R, C; stage_rc(tid * 16 + i * 8192, R, C); const int Rb = Epi::PERM ? ((R & ~31) + perm32(R & 31)) : R;
        voffA[i] = (unsigned)(R * K + C) * 2u; voffB[i] = (unsigned)(Rb * K + C) * 2u; }
    const size_t kstep = (size_t)(BK * 2);
    const size_t hstep = (size_t)HALF * K * 2;
    const size_t tstep = 2 * hstep;
    const unsigned ldsw = (unsigned)wid * 1024u;
    const int aoff = lds_byte(wr * 64 + fr, fq * 8), boff = lds_byte(wc * 32 + fr, fq * 8);
#define PG8_SA(b, h) (((b) * 2 + (h)) * HTB)
#define PG8_SB(b, h) ((4 + (b) * 2 + (h)) * HTB)
#define PG8_STAGE(bufoff, gbase, voff) do { _Pragma("unroll") for (int _i = 0; _i < 2; ++_i) \
        __builtin_amdgcn_global_load_lds((const unsigned*)((const char*)(gbase) + (voff)[_i]), (PG8_LAS unsigned*)(lds + (bufoff) + ldsw + _i * 8192), 16, 0, 0); } while (0)
#define PG8_LDA(dst, b, h) do { _Pragma("unroll") for (int m = 0; m < 4; ++m) _Pragma("unroll") for (int k = 0; k < 2; ++k) dst[m][k] = *(const PG8_LAS bf16x8*)(lds + PG8_SA(b, h) + aoff + m * 2048 + k * 1024); } while (0)
#define PG8_LDB(dst, b, h) do { _Pragma("unroll") for (int n = 0; n < 2; ++n) _Pragma("unroll") for (int k = 0; k < 2; ++k) dst[n][k] = *(const PG8_LAS bf16x8*)(lds + PG8_SB(b, h) + boff + n * 2048 + k * 1024); } while (0)
#define PG8_MMA(ai, bj, At, Bt) do { __builtin_amdgcn_s_setprio(1); _Pragma("unroll") for (int m = 0; m < 4; ++m) _Pragma("unroll") for (int n = 0; n < 2; ++n) _Pragma("unroll") for (int k = 0; k < 2; ++k) \
        acc[ai][bj][m][n] = __builtin_amdgcn_mfma_f32_16x16x32_bf16(Bt[n][k], At[m][k], acc[ai][bj][m][n], 0, 0, 0); __builtin_amdgcn_s_setprio(0); } while (0)
#define PG8_WAIT_V(n) asm volatile("s_waitcnt vmcnt(" #n ")" ::: "memory")
#define PG8_WAIT_L(n) asm volatile("s_waitcnt lgkmcnt(" #n ")" ::: "memory")
#define PG8_BAR __builtin_amdgcn_s_barrier()
#define PG8_SCHED __builtin_amdgcn_sched_barrier(0)
    Unit cur, nxt; int ui = 0;
    if (!S.next(0, cur)) return;
    f32x4 acc[2][2][4][2];
#pragma unroll
    for (int a = 0; a < 2; ++a)
#pragma unroll
        for (int b = 0; b < 2; ++b)
#pragma unroll
            for (int m = 0; m < 4; ++m)
#pragma unroll
                for (int n = 0; n < 2; ++n) acc[a][b][m][n] = (f32x4){0.f, 0.f, 0.f, 0.f};
    bf16x8 At[4][2], B0[2][2], B1[2][2];
    const char* cA = (const char*)g.A + (size_t)cur.pm * tstep; const char* cB = (const char*)g.Bt + (size_t)cur.pn * tstep;
    S.a_ready(cur);
    if constexpr (SP2) {
        PG8_STAGE(PG8_SB(0, 0), cB, voffB); PG8_STAGE(PG8_SB(0, 1), cB + hstep, voffB); PG8_STAGE(PG8_SA(0, 0), cA, voffA); PG8_STAGE(PG8_SA(0, 1), cA + hstep, voffA);
        if (wr == 1) PG8_BAR;
        PG8_WAIT_V(2); PG8_BAR;
        PG8_STAGE(PG8_SB(1, 0), cB + kstep, voffB); PG8_STAGE(PG8_SA(1, 0), cA + kstep, voffA); PG8_STAGE(PG8_SB(1, 1), cB + hstep + kstep, voffB);
        PG8_WAIT_V(6); PG8_BAR;
    } else {
        PG8_STAGE(PG8_SB(0, 0), cB, voffB); PG8_STAGE(PG8_SA(0, 0), cA, voffA); PG8_STAGE(PG8_SB(0, 1), cB + hstep, voffB); PG8_STAGE(PG8_SA(0, 1), cA + hstep, voffA);
        if (wr == 1) PG8_BAR;
        PG8_WAIT_V(4); PG8_BAR;
        PG8_STAGE(PG8_SB(1, 0), cB + kstep, voffB); PG8_STAGE(PG8_SA(1, 0), cA + kstep, voffA); PG8_STAGE(PG8_SB(1, 1), cB + hstep + kstep, voffB);
        PG8_WAIT_V(6); PG8_BAR;
    }
    for (;;) {
        const bool has_next = S.next(ui + 1, nxt);
        const char* nA = has_next ? (const char*)g.A + (size_t)nxt.pm * tstep : cA; const char* nB = has_next ? (const char*)g.Bt + (size_t)nxt.pn * tstep : cB;
        for (int t = 0; t < nt; t += 2) {
            const bool last = (t == nt - 2);
            const char* a1 = cA + (size_t)(t + 1) * kstep;
            const char* a2 = last ? nA : cA + (size_t)(t + 2) * kstep; const char* b2 = last ? nB : cB + (size_t)(t + 2) * kstep;
            const char* a3 = a2 + kstep; const char* b3 = b2 + kstep;
            if (last && has_next) S.a_ready(nxt);
            if constexpr (SP2) {
            PG8_LDB(B0, 0, 0); PG8_LDB(B1, 0, 1); PG8_SCHED; PG8_LDA(At, 0, 0); PG8_STAGE(PG8_SA(1, 1), a1 + hstep, voffA);
            PG8_WAIT_V(8); PG8_WAIT_L(0); PG8_BAR; PG8_MMA(0, 0, At, B0); PG8_MMA(0, 1, At, B1); PG8_BAR; PG8_SCHED;
            PG8_LDA(At, 0, 1); PG8_STAGE(PG8_SB(0, 0), b2, voffB); PG8_STAGE(PG8_SB(0, 1), b2 + hstep, voffB); PG8_STAGE(PG8_SA(0, 0), a2, voffA);
            PG8_WAIT_V(8); PG8_WAIT_L(0); PG8_BAR; PG8_MMA(1, 0, At, B0); PG8_MMA(1, 1, At, B1); PG8_BAR; PG8_SCHED;
            PG8_LDB(B0, 1, 0); PG8_LDB(B1, 1, 1); PG8_SCHED; PG8_LDA(At, 1, 0); PG8_STAGE(PG8_SA(0, 1), a2 + hstep, voffA);
            PG8_WAIT_V(8); PG8_WAIT_L(0); PG8_BAR; PG8_MMA(0, 0, At, B0); PG8_MMA(0, 1, At, B1); PG8_BAR; PG8_SCHED;
            PG8_LDA(At, 1, 1); PG8_STAGE(PG8_SB(1, 0), b3, voffB); PG8_STAGE(PG8_SB(1, 1), b3 + hstep, voffB); PG8_STAGE(PG8_SA(1, 0), a3, voffA);
            PG8_WAIT_V(8); PG8_WAIT_L(0); PG8_BAR; PG8_MMA(1, 0, At, B0); PG8_MMA(1, 1, At, B1); PG8_BAR; PG8_SCHED;
            } else {
            PG8_LDB(B0, 0, 0); PG8_SCHED; PG8_LDA(At, 0, 0); PG8_STAGE(PG8_SA(1, 1), a1 + hstep, voffA);
            PG8_WAIT_L(8); PG8_BAR; PG8_WAIT_L(0); PG8_MMA(0, 0, At, B0); PG8_BAR; PG8_SCHED;
            PG8_LDB(B1, 0, 1); PG8_STAGE(PG8_SB(0, 0), b2, voffB);
            PG8_BAR; PG8_WAIT_L(0); PG8_MMA(0, 1, At, B1); PG8_BAR;
            PG8_LDA(At, 0, 1); PG8_STAGE(PG8_SA(0, 0), a2, voffA);
            PG8_BAR; PG8_WAIT_L(0); PG8_MMA(1, 0, At, B0); PG8_BAR; PG8_SCHED;
            PG8_STAGE(PG8_SB(0, 1), b2 + hstep, voffB);
            PG8_WAIT_V(6); PG8_BAR; PG8_MMA(1, 1, At, B1); PG8_BAR;
            PG8_LDB(B0, 1, 0); PG8_SCHED; PG8_LDA(At, 1, 0); PG8_STAGE(PG8_SA(0, 1), a2 + hstep, voffA);
            PG8_WAIT_L(8); PG8_BAR; PG8_WAIT_L(0); PG8_MMA(0, 0, At, B0); PG8_BAR; PG8_SCHED;
            PG8_LDB(B1, 1, 1); PG8_STAGE(PG8_SB(1, 0), b3, voffB);
            PG8_BAR; PG8_WAIT_L(0); PG8_MMA(0, 1, At, B1); PG8_BAR;
            PG8_LDA(At, 1, 1); PG8_STAGE(PG8_SA(1, 0), a3, voffA);
            PG8_BAR; PG8_WAIT_L(0); PG8_MMA(1, 0, At, B0); PG8_BAR; PG8_SCHED;
            PG8_STAGE(PG8_SB(1, 1), b3 + hstep, voffB);
            PG8_WAIT_V(6); PG8_BAR; PG8_MMA(1, 1, At, B1); PG8_BAR;
            }
        }
        if constexpr (ALIGN_EPI) { if (wr == 0) PG8_BAR; }
        if constexpr (!Epi::AFTER_DRAIN) { E(acc, cur, wr, wc, fr, fq); S.done(cur); }
        if (!has_next) break;
#pragma unroll
        for (int a = 0; a < 2; ++a)
#pragma unroll
            for (int b = 0; b < 2; ++b)
#pragma unroll
                for (int m = 0; m < 4; ++m)
#pragma unroll
                    for (int n = 0; n < 2; ++n) acc[a][b][m][n] = (f32x4){0.f, 0.f, 0.f, 0.f};
        cur = nxt; cA = nA; cB = nB; ++ui;
        if constexpr (ALIGN_EPI) { if (wr == 1) PG8_BAR; }
    }
    PG8_WAIT_V(0);
    if constexpr (!ALIGN_EPI) { if (wr == 0) PG8_BAR; }
    PG8_BAR;
    if constexpr (Epi::AFTER_DRAIN) { E.fused(acc, cur, wr, wc, fr, fq, lds, wid, lane); S.done(cur); }
#undef PG8_SA
#undef PG8_SB
#undef PG8_STAGE
#undef PG8_LDA
#undef PG8_LDB
#undef PG8_MMA
#undef PG8_WAIT_V
#undef PG8_WAIT_L
#undef PG8_BAR
#undef PG8_SCHED
}
}
#define GAS __attribute__((address_space(1)))
#define LAS __attribute__((address_space(3)))
typedef unsigned short bf16;
typedef unsigned v4u __attribute__((ext_vector_type(4)));
typedef float f32x4 __attribute__((ext_vector_type(4)));
typedef short bf16x8 __attribute__((ext_vector_type(8)));
typedef GAS unsigned gu32;
typedef GAS unsigned long long gu64;
#define RLX_AGENT __ATOMIC_RELAXED, __HIP_MEMORY_SCOPE_AGENT
#define LDS_WAIT() asm volatile("s_waitcnt lgkmcnt(0)" ::: "memory")
#define VM_WAIT() asm volatile("s_waitcnt vmcnt(0)" ::: "memory")
__device__ __forceinline__ unsigned long long rt() { return __builtin_amdgcn_s_memrealtime(); }
__device__ __forceinline__ unsigned f2bf(float f) { unsigned u = __builtin_bit_cast(unsigned, f); return (u + 0x7fffu + ((u >> 16) & 1u)) >> 16; }
__device__ __forceinline__ unsigned pk2(float lo, float hi) { return f2bf(lo) | (f2bf(hi) << 16); }

#define XB_TMO      128
#define XB_XCNT(j)  (256  + 64 * (j))
#define XB_XSUB(j)  (1280 + 64 * (j))
#define XB_XGEN(j)  (2304 + 64 * (j))
#define XB_TOP      3328
#define XB_TOPGEN   3392
#define XCD_BAR_WORDS 3456
#define XB_SPIN_CAP (1u << 18)

__device__ __forceinline__ unsigned xb_ld(unsigned* p)              { return __hip_atomic_load(p, __ATOMIC_RELAXED, __HIP_MEMORY_SCOPE_AGENT); }
__device__ __forceinline__ unsigned xb_add(unsigned* p, unsigned v) { return __hip_atomic_fetch_add(p, v, __ATOMIC_RELAXED, __HIP_MEMORY_SCOPE_AGENT); }
__device__ __forceinline__ unsigned xb_xcc_id() { return (unsigned)__builtin_amdgcn_s_getreg((3 << 11) | 20) & 0xFu; }
#define XB_SPIN(cond, bar) do { unsigned _sp = 0; while (cond) { __builtin_amdgcn_s_sleep(1); \
    if ((++_sp & 255u) == 0u) { if (xb_ld(&(bar)[XB_TMO])) break; if (_sp > XB_SPIN_CAP) { atomicAdd(&(bar)[XB_TMO], 1u); break; } } } } while (0)

struct XcdBarrier {
    unsigned* bar; unsigned x;
    volatile LAS unsigned* st;
};

__device__ __forceinline__ XcdBarrier xcd_barrier_post(unsigned* bar, volatile LAS unsigned* st) {
    XcdBarrier b; b.bar = bar; b.x = xb_xcc_id(); b.st = st;
    if (threadIdx.x == 0) (void)xb_add(&bar[XB_XCNT(b.x)], 1u);
    return b;
}
__device__ __forceinline__ void xcd_barrier_complete(unsigned* bar, unsigned x, unsigned& nloc, unsigned& nx) {
    const unsigned G = gridDim.x * gridDim.y * gridDim.z;
    unsigned sum, cnt, mine, sp = 0u;
    for (;;) {
        sum = 0u; cnt = 0u; mine = 0u;
#pragma unroll
        for (unsigned j = 0; j < 16; ++j) { const unsigned c = xb_ld(&bar[XB_XCNT(j)]); sum += c; cnt += (c > 0u) ? 1u : 0u; mine = (j == x) ? c : mine; }
        if (sum == G) break;
        __builtin_amdgcn_s_sleep(1);
        if ((++sp & 255u) == 0u) { if (xb_ld(&bar[XB_TMO])) break; if (sp > XB_SPIN_CAP) { atomicAdd(&bar[XB_TMO], 1u); break; } }
    }
    nloc = mine > 0u ? mine : 1u; nx = cnt > 0u ? cnt : 1u;
}

__device__ __forceinline__ void xcd_barrier(const XcdBarrier& b) {
    asm volatile("s_waitcnt vmcnt(0)" ::: "memory");
    __syncthreads();
    if (threadIdx.x == 0) {
        unsigned* bar = b.bar;
        __builtin_amdgcn_s_waitcnt(0);
        unsigned nloc = b.st[0], nx = b.st[1];
        if (nloc == 0u) { xcd_barrier_complete(bar, b.x, nloc, nx); b.st[0] = nloc; b.st[1] = nx; }
        const unsigned old = xb_add(&bar[XB_XSUB(b.x)], 1u);
        const unsigned gen = old / nloc;
        if (old + 1u == (gen + 1u) * nloc) {
            __builtin_amdgcn_fence(__ATOMIC_RELEASE, "agent");
            asm volatile("s_waitcnt vmcnt(0)" ::: "memory");
            const unsigned og = xb_add(&bar[XB_TOP], 1u);
            const unsigned tg = og / nx;
            if (og + 1u == (tg + 1u) * nx) xb_add(&bar[XB_TOPGEN], 1u);
            else XB_SPIN(xb_ld(&bar[XB_TOPGEN]) == tg, bar);
            __builtin_amdgcn_fence(__ATOMIC_ACQUIRE, "agent");
            xb_add(&bar[XB_XGEN(b.x)], 1u);
            asm volatile("s_waitcnt vmcnt(0)" ::: "memory");
        } else {
            XB_SPIN(xb_ld(&bar[XB_XGEN(b.x)]) == gen, bar);
            __builtin_amdgcn_fence(__ATOMIC_ACQUIRE, "agent");
            asm volatile("s_waitcnt vmcnt(0)" ::: "memory");
        }
    }
    __syncthreads();
}
constexpr int NWAVES = 8, NT = 512;
constexpr int BATCH = 4, SEQ = 8192, D = 1024, FF = 4096, M = BATCH * SEQ, DEPTH = 4;
constexpr int NH = 4, DK = 128, DV = 256, CH = 128, NCH = SEQ / CH, NUNIT = BATCH * NH * NCH;
constexpr int MIN_COLS = 3080;
constexpr float EPS = 1e-6f, GATE_CAP = 15.0f;
constexpr size_t MiB = 1u << 20;
constexpr size_t WS_CTL = 0, CTL_ZERO_BYTES = 1 * MiB;
constexpr size_t WS_SSQ = 1 * MiB;
constexpr size_t WS_XCH = 1 * MiB + 512 * 1024;
constexpr size_t WS_IG = 2 * MiB, WS_LF = 2 * MiB + 512 * 1024;
constexpr size_t WS_BLAST = 3 * MiB, WS_MLOC = 3 * MiB + 4096, WS_MPREV = 3 * MiB + 8192;
constexpr size_t WS_NLOC = 3 * MiB + 512 * 1024, WS_NPREV = 4 * MiB;
constexpr size_t WS_WGT = 4 * MiB + 512 * 1024;
constexpr size_t WS_W = 8 * MiB, W_LAYER = 24 * MiB, W_IN = 0, W_OUT = 6 * MiB, W_UP = 8 * MiB, W_DN = 16 * MiB;
constexpr size_t WS_XB = 104 * MiB;
constexpr size_t WS_S = 168 * MiB;
constexpr size_t WS_HID = WS_S;
constexpr size_t WS_Q = WS_S, WS_K = WS_S + 32 * MiB, WS_V = WS_S + 64 * MiB, WS_O = WS_S + 128 * MiB;
constexpr size_t WS_KVT = WS_S + 192 * MiB, WS_CT = WS_S + 256 * MiB;
constexpr size_t WS_BG = WS_S, WS_U = WS_S + 64 * MiB;
constexpr size_t WS_END = WS_S + 320 * MiB;
constexpr int CW_TMO = 0, CW_CODE = 1, CW_BAR = 4096, CW_SEAM = 16384;
constexpr int RING_OFF = 0, RING_BYTES = 131072, LDSCTL_OFF = RING_BYTES, MISC_OFF = LDSCTL_OFF + 320, LDS_BYTES = 147456;
constexpr int PH_PRO = 0, PH_PER_HL = 6, PH_END = 1 + 8 * PH_PER_HL;

__device__ __forceinline__ int launder_i(int v) { asm volatile("" : "+v"(v)); return v; }
__device__ __forceinline__ float bf2f(bf16 b) { return __uint_as_float(((unsigned)b) << 16); }
__device__ __forceinline__ float wave_sum(float v) {
#pragma unroll
    for (int o = 1; o < 64; o <<= 1) v += __shfl_xor(v, o);
    return v;
}
__device__ __forceinline__ void p0_transpose_item(const float* W, int ldw, int src_col0, int k0, const float* gain, float cscale, bf16* WT, int K, int dst_row0, LAS float* scr, int lane) {
#pragma unroll 8
    for (int i = 0; i < 32; ++i) { const int kk = 2 * i + (lane >> 5); const float gsc = gain ? gain[k0 + kk] * cscale : cscale;
        scr[kk * 33 + (lane & 31)] = W[(size_t)(k0 + kk) * ldw + src_col0 + (lane & 31)] * gsc; }
    LDS_WAIT(); asm volatile("" ::: "memory");
    const int c = lane & 7;
#pragma unroll
    for (int j = 0; j < 4; ++j) { const int n = (lane >> 3) + 8 * j; const LAS float* s = scr + (8 * c) * 33 + n;
        v4u o; o.x = pk2(s[0 * 33], s[1 * 33]); o.y = pk2(s[2 * 33], s[3 * 33]); o.z = pk2(s[4 * 33], s[5 * 33]); o.w = pk2(s[6 * 33], s[7 * 33]);
        *(GAS v4u*)(WT + (size_t)(dst_row0 + n) * K + k0 + 8 * c) = o; }
    LDS_WAIT(); asm volatile("" ::: "memory");
}
struct Args { const float* in[11]; float* out; unsigned char* ws; int lo, hi, multi, pad; };

__device__ __forceinline__ void gates_naive(const bf16* xb, const float* Win, const float* g0, const float* bias, const float* ssq, float* ig, float* lf, int gtid, int gthreads) {
    for (int item = gtid; item < M * 8; item += gthreads) { const int row = item >> 3, j = item & 7; float s = 0.f;
        for (int k = 0; k < D; ++k) s += bf2f(xb[(size_t)row * D + k]) * g0[k] * Win[(size_t)k * MIN_COLS + 3072 + j];
        const float4 q = *(const float4*)(ssq + (size_t)row * 4); const float rs = 1.0f / sqrtf((q.x + q.y + q.z + q.w) * (1.0f / D) + EPS);
        float v = s * rs + bias[j]; v = GATE_CAP * tanhf(v / GATE_CAP);
        if (j < 4) ig[(size_t)row * 4 + j] = v; else lf[(size_t)row * 4 + (j - 4)] = fminf(v, 0.f) - log1pf(expf(-fabsf(v))); }
}
__device__ __forceinline__ void b1_naive(const bf16* kb, const bf16* vb, const float* ig, const float* lf, bf16* kvT, float* nloc, float* blast, float* mloc, LAS float* sm, int tid, int G) {
    LAS float* s_ig = sm; LAS float* s_lf = sm + 128; LAS float* s_b = sm + 256; LAS float* s_w = sm + 384;
    for (int u = blockIdx.x; u < NUNIT; u += G) {
        const int b = u >> 8, h = (u >> 6) & 3, c = u & 63; const size_t row0 = (size_t)b * SEQ + c * CH;
        if (tid < 128) { s_ig[tid] = ig[(row0 + tid) * 4 + h]; s_lf[tid] = lf[(row0 + tid) * 4 + h]; }
        __syncthreads();
        if (tid == 0) { float a = 0.f; for (int l = 0; l < 128; ++l) { a += s_lf[l]; s_b[l] = a; } const float bl = a; float mx = -INFINITY;
            for (int l = 0; l < 128; ++l) mx = fmaxf(mx, bl - s_b[l] + s_ig[l]);
            for (int l = 0; l < 128; ++l) s_w[l] = expf(bl - s_b[l] + s_ig[l] - mx);
            blast[u] = bl; mloc[u] = mx; }
        __syncthreads();
        const int d = tid & 127, eq = tid >> 7;
        for (int j = 0; j < 64; ++j) { const int e = eq + 4 * j; float s = 0.f;
            for (int l = 0; l < 128; ++l) s += s_w[l] * bf2f(kb[(row0 + l) * 512 + h * 128 + d]) * bf2f(vb[(row0 + l) * 1024 + h * 256 + e]);
            kvT[((size_t)u * 256 + e) * 128 + d] = (bf16)f2bf(s); }
        if (tid < 128) { float s = 0.f; for (int l = 0; l < 128; ++l) s += s_w[l] * bf2f(kb[(row0 + l) * 512 + h * 128 + tid]); nloc[(size_t)u * 128 + tid] = s; }
        __syncthreads();
    }
}
__device__ __forceinline__ void b2_naive(const bf16* kvT, bf16* CT, const float* nloc, float* nprev, const float* blast, const float* mloc, float* mprev, int gtid, int gthreads) {
    for (int idx = gtid; idx < 16 * 32768; idx += gthreads) { const int bh = idx >> 15, ed = idx & 32767; float m = 0.f, C = 0.f;
        for (int c = 0; c < NCH; ++c) { const int u = bh * 64 + c; const size_t off = (size_t)u * 32768 + ed; CT[off] = (bf16)f2bf(C);
            const float bl = blast[u], ml = mloc[u], mn = fmaxf(bl + m, ml), a = expf(bl + m - mn), s = expf(ml - mn); C = a * C + s * bf2f(kvT[off]); m = mn; } }
    for (int idx = gtid; idx < 16 * 128; idx += gthreads) { const int bh = idx >> 7, d = idx & 127; float m = 0.f, n = 0.f;
        for (int c = 0; c < NCH; ++c) { const int u = bh * 64 + c; nprev[(size_t)u * 128 + d] = n;
            const float bl = blast[u], ml = mloc[u], mn = fmaxf(bl + m, ml), a = expf(bl + m - mn), s = expf(ml - mn); n = a * n + s * nloc[(size_t)u * 128 + d]; m = mn; } }
    for (int idx = gtid; idx < 16; idx += gthreads) { float m = 0.f;
        for (int c = 0; c < NCH; ++c) { const int u = idx * 64 + c; mprev[u] = m; m = fmaxf(blast[u] + m, mloc[u]); } }
}
__device__ __forceinline__ void b3_naive(const bf16* qb, const bf16* kb, const bf16* vb, bf16* ob, const bf16* CT, const float* nprev, const float* mprev, const float* ig, const float* lf, const float* ghn,
                                         LAS float* sm, int tid, int G) {
    const int sb = tid >> 7, st = tid & 127;
    LAS float* s_a = sm + sb * 512; LAS float* s_P = s_a + 128; LAS float* s_red = s_a + 256; LAS float* s_misc = s_a + 384;
    const int niter = (M * NH) / (G * 4);
    for (int it = 0; it < niter; ++it) {
        const int item = (it * G + blockIdx.x) * 4 + sb; const int row = item >> 2, h = item & 3;
        const int b = row >> 13, tpos = row & 8191, c = tpos >> 7, tl = tpos & 127, unit = (b * 4 + h) * 64 + c; const size_t row0 = (size_t)row - tl;
        { float bs = 0.f; for (int l = 0; l <= st; ++l) bs += lf[(row0 + l) * 4 + h]; s_a[st] = ig[(row0 + st) * 4 + h] - bs; if (st == tl) s_misc[0] = bs; }
        __syncthreads();
        float cm = -INFINITY; for (int s = 0; s <= tl; ++s) cm = fmaxf(cm, s_a[s]);
        const float mp = mprev[unit], mm = fmaxf(cm, mp), bt = s_misc[0];
        const bf16* qrow = qb + (size_t)row * 512 + h * 128;
        { float dot = 0.f; const bf16* krow = kb + (row0 + st) * 512 + h * 128; for (int d = 0; d < 128; ++d) dot += bf2f(qrow[d]) * bf2f(krow[d]);
          s_P[st] = (st <= tl) ? dot * expf(s_a[st] - mm) : 0.f; }
        __syncthreads();
        const float inter = expf(mp - mm);
        float den = 0.f; for (int s = 0; s < 128; ++s) den += s_P[s];
        { float qn = 0.f; for (int d = 0; d < 128; ++d) qn += bf2f(qrow[d]) * nprev[(size_t)unit * 128 + d]; den += inter * qn; }
        const float dn = fmaxf(fabsf(den), expf(-(bt + mm)));
        float hv0, hv1;
        { const int e = st; float num = 0.f; for (int s = 0; s <= tl; ++s) num += s_P[s] * bf2f(vb[(row0 + s) * 1024 + h * 256 + e]);
          float qc = 0.f; const bf16* crow = CT + ((size_t)unit * 256 + e) * 128; for (int d = 0; d < 128; ++d) qc += bf2f(qrow[d]) * bf2f(crow[d]); hv0 = (num + inter * qc) / dn; }
        { const int e = st + 128; float num = 0.f; for (int s = 0; s <= tl; ++s) num += s_P[s] * bf2f(vb[(row0 + s) * 1024 + h * 256 + e]);
          float qc = 0.f; const bf16* crow = CT + ((size_t)unit * 256 + e) * 128; for (int d = 0; d < 128; ++d) qc += bf2f(qrow[d]) * bf2f(crow[d]); hv1 = (num + inter * qc) / dn; }
        s_red[st] = hv0 * hv0 + hv1 * hv1;
        __syncthreads();
        float ss = 0.f; for (int i = 0; i < 128; ++i) ss += s_red[i];
        const float rn = 1.0f / sqrtf(ss * (1.0f / 256.0f) + EPS);
        { const size_t oi = (size_t)row * 1024 + h * 256 + st; ob[oi] = (bf16)f2bf(hv0 * rn * ghn[h * 256 + st] * bf2f(ob[oi])); }
        { const size_t oi = (size_t)row * 1024 + h * 256 + st + 128; ob[oi] = (bf16)f2bf(hv1 * rn * ghn[h * 256 + st + 128] * bf2f(ob[oi])); }
        __syncthreads();
    }
}
__device__ __forceinline__ void conv_phase(bf16* bg, const bf16* ub, const float* wc, int gtid, int gthreads) {
    for (int idx = gtid; idx < M * 128; idx += gthreads) { const int row = idx >> 7, ch0 = (idx & 127) * 8, t = row & (SEQ - 1);
        const v4u z = {0u, 0u, 0u, 0u};
        const v4u u0 = *(const GAS v4u*)(ub + (size_t)row * D + ch0);
        const v4u u1 = t >= 1 ? *(const GAS v4u*)(ub + (size_t)(row - 1) * D + ch0) : z;
        const v4u u2 = t >= 2 ? *(const GAS v4u*)(ub + (size_t)(row - 2) * D + ch0) : z;
        const v4u bb = *(const GAS v4u*)(bg + (size_t)row * D + ch0);
        v4u o;
#pragma unroll
        for (int j = 0; j < 4; ++j) { const int c = ch0 + 2 * j;
            const float a0 = __uint_as_float(u0[j] << 16), a1 = __uint_as_float(u0[j] & 0xffff0000u), b0 = __uint_as_float(u1[j] << 16), b1 = __uint_as_float(u1[j] & 0xffff0000u);
            const float c0 = __uint_as_float(u2[j] << 16), c1 = __uint_as_float(u2[j] & 0xffff0000u), g0 = __uint_as_float(bb[j] << 16), g1 = __uint_as_float(bb[j] & 0xffff0000u);
            const float y0 = g0 * (wc[c] * c0 + wc[D + c] * b0 + wc[2 * D + c] * a0), y1 = g1 * (wc[c + 1] * c1 + wc[D + c + 1] * b1 + wc[2 * D + c + 1] * a1);
            o[j] = pk2(y0, y1); }
        *(GAS v4u*)(bg + (size_t)row * D + ch0) = o; }
}
__device__ __forceinline__ void postnorm_naive(float* hout, bf16* xb, const float* g, float* ssq, bool last, int gw, int ngw, int lane) {
    for (int row = gw; row < M; row += ngw) {
        float* hr = hout + (size_t)row * D; bf16* xr = xb + (size_t)row * D;
        f32x4 hv[4]; float s = 0.f;
#pragma unroll
        for (int j = 0; j < 4; ++j) { hv[j] = *(const GAS f32x4*)(hr + 4 * lane + 256 * j); s += (hv[j][0] * hv[j][0] + hv[j][1] * hv[j][1]) + (hv[j][2] * hv[j][2] + hv[j][3] * hv[j][3]); }
        const float c = 1.0f / sqrtf(wave_sum(s) * (1.0f / D) + EPS); float s2 = 0.f;
#pragma unroll
        for (int j = 0; j < 4; ++j) { const int col = 4 * lane + 256 * j; const unsigned long long xw = *(const GAS unsigned long long*)(xr + col); const f32x4 gv = *(const GAS f32x4*)(g + col);
            const unsigned lo = (unsigned)xw, hi = (unsigned)(xw >> 32);
            f32x4 xn; xn[0] = __uint_as_float(lo << 16) + c * hv[j][0] * gv[0]; xn[1] = __uint_as_float(lo & 0xffff0000u) + c * hv[j][1] * gv[1];
            xn[2] = __uint_as_float(hi << 16) + c * hv[j][2] * gv[2]; xn[3] = __uint_as_float(hi & 0xffff0000u) + c * hv[j][3] * gv[3];
            const unsigned p0 = pk2(xn[0], xn[1]), p1 = pk2(xn[2], xn[3]);
            const float r0 = __uint_as_float(p0 << 16), r1 = __uint_as_float(p0 & 0xffff0000u), r2 = __uint_as_float(p1 << 16), r3 = __uint_as_float(p1 & 0xffff0000u);
            s2 += (r0 * r0 + r1 * r1) + (r2 * r2 + r3 * r3);
            *(GAS unsigned long long*)(xr + col) = (unsigned long long)p0 | ((unsigned long long)p1 << 32);
            if (last) *(GAS f32x4*)(hr + col) = xn; }
        s2 = wave_sum(s2);
        if (lane == 0) *(GAS f32x4*)(ssq + (size_t)row * 4) = (f32x4){s2, 0.f, 0.f, 0.f};
    }
}

__global__ void __launch_bounds__(NT, 2) mk_fwd(Args args) {
    extern __shared__ __attribute__((aligned(16))) unsigned char lds[];
    LAS unsigned char* L = (LAS unsigned char*)lds;
    volatile LAS unsigned* MISC = (volatile LAS unsigned*)(L + MISC_OFF);
    const int tid = threadIdx.x, lane = tid & 63, wave = __builtin_amdgcn_readfirstlane(tid >> 6), G = gridDim.x;
    const int gtid = blockIdx.x * NT + tid, gthreads = G * NT, gw = blockIdx.x * NWAVES + wave, ngw = G * NWAVES;
    unsigned char* ws = args.ws;
    gu32* ctl = (gu32*)(ws + WS_CTL);
    const float* x_in = args.in[0]; const float* norm_g = args.in[1]; const float* w_in_m = args.in[2]; const float* b_gates = args.in[3]; const float* g_hnorm = args.in[4];
    const float* w_out_m = args.in[5]; const float* w_in_c = args.in[6]; const float* w_conv = args.in[7]; const float* w_out_c = args.in[8]; const float* w_up = args.in[9]; const float* w_dn = args.in[10];
    float* ssq = (float*)(ws + WS_SSQ); float* igp = (float*)(ws + WS_IG); float* lfp = (float*)(ws + WS_LF);
    float* blast = (float*)(ws + WS_BLAST); float* mloc = (float*)(ws + WS_MLOC); float* mprev = (float*)(ws + WS_MPREV);
    float* nloc = (float*)(ws + WS_NLOC); float* nprev = (float*)(ws + WS_NPREV);
    bf16* xb = (bf16*)(ws + WS_XB); bf16* hid = (bf16*)(ws + WS_HID);
    bf16* qb = (bf16*)(ws + WS_Q); bf16* kb = (bf16*)(ws + WS_K); bf16* vb = (bf16*)(ws + WS_V); bf16* ob = (bf16*)(ws + WS_O);
    bf16* kvT = (bf16*)(ws + WS_KVT); bf16* CT = (bf16*)(ws + WS_CT); bf16* bgb = (bf16*)(ws + WS_BG); bf16* ub = (bf16*)(ws + WS_U);
    for (int u = tid; u < (LDS_BYTES - LDSCTL_OFF) / 4; u += NT) ((LAS unsigned*)(L + LDSCTL_OFF))[u] = 0u;
    __syncthreads();
    const int lo = args.lo, hi = args.hi;
    XcdBarrier bar; bar.bar = (unsigned*)(ctl + CW_BAR); bar.x = 0; bar.st = nullptr;
    if (!args.multi) bar = xcd_barrier_post((unsigned*)(ctl + CW_BAR), MISC + 8);
#define IN(id) (lo <= (id) && (id) < hi)
#define SEAM(id) do { if (hi > (id) + 1) xcd_barrier(bar); } while (0)

    if (IN(PH_PRO)) {
        LAS float* scr = (LAS float*)(L + RING_OFF + wave * 16384);
        constexpr int I_IN = 16 * 96, I_OUT = 16 * 32, I_UP = 16 * 128, I_DN = 64 * 32, I_LAYER = I_IN + I_OUT + I_UP + I_DN;
        for (int it = gw; it < DEPTH * I_LAYER; it += ngw) {
            const int Ly = it / I_LAYER, j = Ly >> 1; int r = it % I_LAYER; const float* g = norm_g + (size_t)Ly * 4 * D;
            bf16* wl = (bf16*)(ws + WS_W + (size_t)Ly * W_LAYER);
            if (r < I_IN) { const int kb_ = r / 96, nb = r % 96, n0 = nb * 32;
                if (!(Ly & 1)) p0_transpose_item(w_in_m + (size_t)j * D * MIN_COLS, MIN_COLS, n0, kb_ * 64, g, (n0 >= 512 && n0 < 1024) ? 0.08838834764831845f : 1.0f, wl + W_IN / 2, D, n0, scr, lane);
                else { int src; if (n0 < 2048) { const int pn = n0 >> 8, within = n0 & 255; src = within < 128 ? 1024 + 128 * pn + within : 2048 + 128 * pn + (within - 128); } else src = n0 - 2048;
                    p0_transpose_item(w_in_c + (size_t)j * D * 3072, 3072, src, kb_ * 64, g, 1.0f, wl + W_IN / 2, D, n0, scr, lane); }
                continue; } r -= I_IN;
            if (r < I_OUT) { const int kb_ = r / 32, nb = r % 32; p0_transpose_item(((Ly & 1) ? w_out_c : w_out_m) + (size_t)j * D * D, D, nb * 32, kb_ * 64, nullptr, 1.0f, wl + W_OUT / 2, D, nb * 32, scr, lane); continue; } r -= I_OUT;
            if (r < I_UP) { const int kb_ = r / 128, nb = r % 128; p0_transpose_item(w_up + (size_t)Ly * D * FF, FF, nb * 32, kb_ * 64, g + 2 * D, 1.0f, wl + W_UP / 2, D, nb * 32, scr, lane); continue; } r -= I_UP;
            { const int kb_ = r / 32, nb = r % 32; p0_transpose_item(w_dn + (size_t)Ly * FF * D, D, nb * 32, kb_ * 64, nullptr, 1.0f, wl + W_DN / 2, FF, nb * 32, scr, lane); }
        }
        for (int row = gw; row < M; row += ngw) { const float* xr = x_in + (size_t)row * D; bf16* orow = xb + (size_t)row * D; float s2 = 0.f;
#pragma unroll
            for (int j = 0; j < 4; ++j) { const int col = 4 * lane + 256 * j; const f32x4 v = *(const GAS f32x4*)(xr + col); const unsigned p0 = pk2(v[0], v[1]), p1 = pk2(v[2], v[3]);
                const float r0 = __uint_as_float(p0 << 16), r1 = __uint_as_float(p0 & 0xffff0000u), r2 = __uint_as_float(p1 << 16), r3 = __uint_as_float(p1 & 0xffff0000u);
                s2 += (r0 * r0 + r1 * r1) + (r2 * r2 + r3 * r3); *(GAS unsigned long long*)(orow + col) = (unsigned long long)p0 | ((unsigned long long)p1 << 32); }
            s2 = wave_sum(s2); if (lane == 0) *(GAS f32x4*)(ssq + (size_t)row * 4) = (f32x4){s2, 0.f, 0.f, 0.f}; }
        SEAM(PH_PRO);
    }

    for (int hl = 0; hl < 2 * DEPTH; ++hl) {
        const int Ly = hl >> 1, j = Ly >> 1, pid = 1 + hl * PH_PER_HL;
        const float* g = norm_g + (size_t)Ly * 4 * D;
        const bf16* wl = (const bf16*)(ws + WS_W + (size_t)Ly * W_LAYER);
        const bf16* nA; const bf16* nB; int nK; const float* ngain;
        if (!(hl & 1)) {
            if (!(Ly & 1)) {
                if (IN(pid + 0)) {
                    gates_naive(xb, w_in_m + (size_t)j * D * MIN_COLS, g, b_gates + j * 8, ssq, igp, lfp, blockIdx.x * NT + launder_i(tid), gthreads);
                    pg8::Gemm gm{xb, wl + W_IN / 2, M, 3072, D}; pg8::StaticOrder S; S.init(M, 3072, G, (int)blockIdx.x);
                    pg8::EpiMlstmIn E{qb, kb, vb, ob, ssq};
                    pg8::gemm_phase<pg8::EpiMlstmIn, pg8::StaticOrder, true, true>(L + RING_OFF, gm, S, E, launder_i(tid));
                    SEAM(pid + 0);
                }
                if (IN(pid + 1)) { b1_naive(kb, vb, igp, lfp, kvT, nloc, blast, mloc, (LAS float*)(L + RING_OFF), launder_i(tid), G); SEAM(pid + 1); }
                if (IN(pid + 2)) { b2_naive(kvT, CT, nloc, nprev, blast, mloc, mprev, blockIdx.x * NT + launder_i(tid), gthreads); SEAM(pid + 2); }
                if (IN(pid + 3)) { b3_naive(qb, kb, vb, ob, CT, nprev, mprev, igp, lfp, g_hnorm + (size_t)j * D, (LAS float*)(L + RING_OFF), launder_i(tid), G); SEAM(pid + 3); }
                nA = ob;
            } else {
                if (IN(pid + 0)) {
                    pg8::Gemm gm{xb, wl + W_IN / 2, M, 3072, D}; pg8::StaticOrder S; S.init(M, 3072, G, (int)blockIdx.x);
                    pg8::EpiConvIn E{ub, bgb, ssq};
                    pg8::gemm_phase<pg8::EpiConvIn, pg8::StaticOrder, true, true>(L + RING_OFF, gm, S, E, launder_i(tid));
                    SEAM(pid + 0);
                }
                if (IN(pid + 1)) { conv_phase(bgb, ub, w_conv + (size_t)j * 3 * D, blockIdx.x * NT + launder_i(tid), gthreads); SEAM(pid + 1); }
                nA = bgb;
            }
            nB = wl + W_OUT / 2; nK = D; ngain = g + D;
        } else {
            if (IN(pid + 0)) {
                pg8::Gemm gm{xb, wl + W_UP / 2, M, FF, D}; pg8::StaticOrder S; S.init(M, FF, G, (int)blockIdx.x);
                pg8::EpiUp E{hid, ssq};
                pg8::gemm_phase<pg8::EpiUp, pg8::StaticOrder, true, true>(L + RING_OFF, gm, S, E, launder_i(tid));
                SEAM(pid + 0);
            }
            nA = hid; nB = wl + W_DN / 2; nK = FF; ngain = g + 3 * D;
        }
        if (IN(pid + 4)) {
            pg8::Gemm gm{nA, nB, M, D, nK}; pg8::StaticOrder S; S.init(M, D, G, (int)blockIdx.x);
            pg8::EpiF32P E{args.out, D};
            pg8::gemm_phase<pg8::EpiF32P, pg8::StaticOrder, true, true>(L + RING_OFF, gm, S, E, launder_i(tid));
            SEAM(pid + 4);
        }
        if (IN(pid + 5)) { postnorm_naive(args.out, xb, ngain, ssq, hl == 2 * DEPTH - 1, gw, ngw, launder_i(lane)); SEAM(pid + 5); }
    }
#undef IN
#undef SEAM
}

extern "C" void kernel_launch(void* const* d_in, const int* in_sizes, int n_in, void* d_out, int out_size, void* d_ws, size_t ws_size, hipStream_t stream) {
    static int grid = 0;
    if (grid == 0) {
        if (n_in != 11 || in_sizes[0] != M * D || out_size != M * D || ws_size < WS_END) { fprintf(stderr, "kernel_launch: unexpected shapes: n_in %d in0 %d out %d ws %zu (need %zu)\n", n_in, n_in > 0 ? in_sizes[0] : -1, out_size, ws_size, (size_t)WS_END); grid = -1; return; }
        int dev = 0, cus = 0, per_cu = 0;
        if (hipGetDevice(&dev) != hipSuccess || hipDeviceGetAttribute(&cus, hipDeviceAttributeMultiprocessorCount, dev) != hipSuccess) { grid = -1; return; }
        if (hipFuncSetAttribute((const void*)mk_fwd, hipFuncAttributeMaxDynamicSharedMemorySize, LDS_BYTES) != hipSuccess) { fprintf(stderr, "kernel_launch: hipFuncSetAttribute failed\n"); grid = -1; return; }
        if (hipOccupancyMaxActiveBlocksPerMultiprocessor(&per_cu, (const void*)mk_fwd, NT, LDS_BYTES) != hipSuccess || per_cu < 1) fprintf(stderr, "kernel_launch: occupancy query reports %d\n", per_cu);
        (void)hipGetLastError();
        grid = cus;
        if (grid != 256) fprintf(stderr, "kernel_launch: %d CUs (built for 256)\n", grid);
    }
    if (grid < 0) return;
    if (hipMemsetAsync((char*)d_ws + WS_CTL, 0, CTL_ZERO_BYTES, stream) != hipSuccess) return;
    Args a{};
    for (int i = 0; i < 11; ++i) a.in[i] = (const float*)d_in[i];
    a.out = (float*)d_out; a.ws = (unsigned char*)d_ws; a.pad = 0;
#if MK_MULTI
    a.multi = 1;
    int ids[64]; int n = 0; ids[n++] = PH_PRO;
    for (int hl = 0; hl < 2 * DEPTH; ++hl) { const int Ly = hl >> 1, pid = 1 + hl * PH_PER_HL;
        if (!(hl & 1)) { ids[n++] = pid; ids[n++] = pid + 1; if (!(Ly & 1)) { ids[n++] = pid + 2; ids[n++] = pid + 3; } } else ids[n++] = pid;
        ids[n++] = pid + 4; ids[n++] = pid + 5; }
    for (int i = 0; i < n; ++i) { a.lo = ids[i]; a.hi = ids[i] + 1; hipLaunchKernelGGL(mk_fwd, dim3(grid), dim3(NT), LDS_BYTES, stream, a); }
#else
    a.multi = 0; a.lo = 0; a.hi = PH_END;
    hipLaunchKernelGGL(mk_fwd, dim3(grid), dim3(NT), LDS_BYTES, stream, a);
#endif
    const hipError_t le = hipPeekAtLastError();
    if (le != hipSuccess) fprintf(stderr, "kernel_launch: launch failed: %s\n", hipGetErrorName(le));
}
```

```cpp
#include <hip/hip_runtime.h>
#include <cstdio>
#include <cstdint>
#include <cmath>
#ifndef MK_MULTI
#define MK_MULTI 0
#endif
#ifndef NAIVE_GATES
#define NAIVE_GATES 0
#endif
#ifndef NAIVE_B1
#define NAIVE_B1 0
#endif
#ifndef NAIVE_B2
#define NAIVE_B2 0
#endif
#ifndef NAIVE_B3
#define NAIVE_B3 0
#endif
#ifndef PROBE_CLASS
#define PROBE_CLASS (-1)
#endif
#ifndef PROBE_GAIN
#define PROBE_GAIN 8
#endif
namespace pg8 {
#define PG8_LAS __attribute__((address_space(3)))
typedef unsigned short bf16_t;
typedef short bf16x8 __attribute__((ext_vector_type(8)));
typedef float f32x4 __attribute__((ext_vector_type(4)));
typedef unsigned u32x4 __attribute__((ext_vector_type(4)));
constexpr int BM = 256, BK = 64, HALF = 128, HTB = HALF * BK * 2  , STAGE_BYTES = 8 * HTB, NXCD = 8, WGM = 8;

__host__ __device__ __forceinline__ int lds_byte(int r, int c) { const int st = (r >> 4) * 2 + (c >> 5), rr = r & 15, cc = c & 31, ob = rr * 64 + cc * 2; return st * 1024 + (ob ^ (((ob >> 9) & 1) << 5)); }
__host__ __device__ __forceinline__ void stage_rc(int b, int& R, int& C) { const int st = b / 1024, sb = b % 1024, swz = sb ^ (((sb >> 9) & 1) << 5); R = (st >> 1) * 16 + swz / 64; C = (st & 1) * 32 + (swz % 64) / 2; }
__host__ __device__ __forceinline__ int perm32(int rho) { const int n = rho >> 4, i = rho & 15; return 8 * (i >> 2) + 4 * n + (i & 3); }

struct Unit { int pm, pn; };
struct Gemm { const bf16_t* A; const bf16_t* Bt; int M, N, K; };

struct StaticOrder {
    int nM, nN, nwg, G, c, nrev;
    __host__ __device__ void init(int M, int N, int G_, int c_, int rev = 0) { nM = M / BM; nN = N / BM; nwg = nM * nN; G = G_; c = c_; nrev = (rev && nwg % G_ == 0) ? nwg / G_ : 0; }
    __host__ __device__ bool next(int i, Unit& u) const {
        const long L = (long)((nrev > 0 && i < nrev) ? (nrev - 1 - i) : i) * G + c; if (L >= nwg || (nrev > 0 && i >= nrev)) return false;
        int wgid = (int)L; { const int q = nwg / NXCD, r = nwg % NXCD, xcd = wgid % NXCD, off = wgid / NXCD; wgid = (xcd < r ? xcd * (q + 1) : r * (q + 1) + (xcd - r) * q) + off; }
        const int nig = WGM * nN, gid = wgid / nig, fm = gid * WGM, gsz = (nM - fm) < WGM ? (nM - fm) : WGM;
        u.pm = fm + ((wgid % nig) % gsz); u.pn = (wgid % nig) / gsz; return true;
    }
    __device__ __forceinline__ void a_ready(const Unit&) const {}
    __device__ __forceinline__ void done(const Unit&) const {}
};

__device__ __forceinline__ unsigned cvt_pk_bf16(float lo, float hi) { unsigned r; asm volatile("v_cvt_pk_bf16_f32 %0, %1, %2" : "=v"(r) : "v"(lo), "v"(hi)); return r; }
constexpr float RMS_EPS = 1e-6f;
constexpr unsigned SSQ_PLANE = 32768u;
__device__ __forceinline__ float rstd_row(const float* ssq, unsigned row) { const f32x4 s = *(const f32x4*)(ssq + row * 4u); return 1.0f / sqrtf(((s[0] + s[1]) + (s[2] + s[3])) * (1.0f / 1024.0f) + RMS_EPS); }
__device__ __forceinline__ u32x4 pack8(f32x4 v0, f32x4 v1) { u32x4 w; w.x = cvt_pk_bf16(v0[0], v0[1]); w.y = cvt_pk_bf16(v0[2], v0[3]); w.z = cvt_pk_bf16(v1[0], v1[1]); w.w = cvt_pk_bf16(v1[2], v1[3]); return w; }
__device__ __forceinline__ unsigned launder0() { unsigned z = 0u; asm volatile("" : "+v"(z)); return z; }
__device__ __forceinline__ u32x4 xlane4(int xlane_src, u32x4 w) { u32x4 r; r.x = (unsigned)__builtin_amdgcn_ds_bpermute(xlane_src, (int)w.x); r.y = (unsigned)__builtin_amdgcn_ds_bpermute(xlane_src, (int)w.y);
    r.z = (unsigned)__builtin_amdgcn_ds_bpermute(xlane_src, (int)w.z); r.w = (unsigned)__builtin_amdgcn_ds_bpermute(xlane_src, (int)w.w); return r; }
__device__ __forceinline__ float sigm(float x) { return __builtin_amdgcn_rcpf(1.0f + __expf(-x)); }

#define PG8_PREF_HOOKS \
    __device__ __forceinline__ f32x4 pref_load(const Unit& u, int tid) const { f32x4 v = {0.f, 0.f, 0.f, 0.f}; if (tid < 256) { const unsigned r = (unsigned)(u.pm * BM + tid); v[0] = ssq[r]; v[1] = ssq[SSQ_PLANE + r]; v[2] = ssq[2u * SSQ_PLANE + r]; v[3] = ssq[3u * SSQ_PLANE + r]; } return v; } \
    __device__ __forceinline__ void pref_store(const f32x4 v, int buf, int tid) const { if (tid < 256) tab[buf * 256 + tid] = 1.0f / sqrtf(((v[0] + v[1]) + (v[2] + v[3])) * (1.0f / 1024.0f) + RMS_EPS); }
struct EpiMlstmIn { static constexpr bool PERM = true, AFTER_DRAIN = false, PREF = true;
    bf16_t *q, *k, *v, *o; const float* ssq; PG8_LAS float* tab;
    PG8_PREF_HOOKS
    __device__ __forceinline__ void operator()(const f32x4 (&acc)[2][2][4][2], const Unit& u, int wr, int wc, int fr, int fq, int buf) const {
        const int pn = u.pn; bf16_t* base; int ldc, colt; bool sig = false;
        if (pn < 2) { base = q; ldc = 512; colt = pn * 256; } else if (pn < 4) { base = k; ldc = 512; colt = (pn - 2) * 256; }
        else if (pn < 8) { base = v; ldc = 1024; colt = (pn - 4) * 256; } else { base = o; ldc = 1024; colt = (pn - 8) * 256; sig = true; }
        const unsigned z = launder0(), ln = fq * 16 + fr + z; const int xs = (int)(((ln & 3u) * 16u + (ln >> 2)) * 4u);
        const unsigned row0 = u.pm * BM + wr * 64 + fr + z, prow0 = u.pm * BM + wr * 64 + (ln >> 2), pcol0 = colt + wc * 32 + 8 * (ln & 3u);
#pragma unroll
        for (int ai = 0; ai < 2; ++ai)
#pragma unroll
            for (int m = 0; m < 4; ++m) { const unsigned row = row0 + ai * HALF + m * 16; const float rs = tab[buf * 256 + (int)(row - u.pm * BM)]; bf16_t* rowp = base + ((prow0 + ai * HALF + m * 16) * (unsigned)ldc + pcol0);
#pragma unroll
                for (int bj = 0; bj < 2; ++bj) { f32x4 v0 = acc[ai][bj][m][0] * rs, v1 = acc[ai][bj][m][1] * rs;
                    if (sig) {
#pragma unroll
                        for (int j = 0; j < 4; ++j) { v0[j] = sigm(v0[j]); v1[j] = sigm(v1[j]); } }
                    *(u32x4*)(rowp + bj * HALF) = xlane4(xs, pack8(v0, v1)); } }
    }
};
struct EpiConvIn { static constexpr bool PERM = true, AFTER_DRAIN = false, PREF = true;
    bf16_t *ub, *bg; const float* ssq; PG8_LAS float* tab;
    PG8_PREF_HOOKS
    __device__ __forceinline__ void operator()(const f32x4 (&acc)[2][2][4][2], const Unit& u, int wr, int wc, int fr, int fq, int buf) const {
        const int pn = u.pn; const unsigned z = launder0(), ln = fq * 16 + fr + z; const int xs = (int)(((ln & 3u) * 16u + (ln >> 2)) * 4u);
        const unsigned row0 = u.pm * BM + wr * 64 + fr + z, prow0 = u.pm * BM + wr * 64 + (ln >> 2);
        if (pn < 8) { const unsigned pcol0 = pn * 128 + wc * 32 + 8 * (ln & 3u);
#pragma unroll
            for (int ai = 0; ai < 2; ++ai)
#pragma unroll
                for (int m = 0; m < 4; ++m) { const unsigned row = row0 + ai * HALF + m * 16; const float rs = tab[buf * 256 + (int)(row - u.pm * BM)], rs2 = rs * rs;
                    const f32x4 v0 = acc[ai][0][m][0] * acc[ai][1][m][0] * rs2, v1 = acc[ai][0][m][1] * acc[ai][1][m][1] * rs2;
                    *(u32x4*)(ub + ((prow0 + ai * HALF + m * 16) * 1024u + pcol0)) = xlane4(xs, pack8(v0, v1)); }
        } else { const unsigned pcol0 = (pn - 8) * 256 + wc * 32 + 8 * (ln & 3u);
#pragma unroll
            for (int ai = 0; ai < 2; ++ai)
#pragma unroll
                for (int m = 0; m < 4; ++m) { const unsigned row = row0 + ai * HALF + m * 16; const float rs = tab[buf * 256 + (int)(row - u.pm * BM)]; bf16_t* rowp = bg + ((prow0 + ai * HALF + m * 16) * 1024u + pcol0);
#pragma unroll
                    for (int bj = 0; bj < 2; ++bj) *(u32x4*)(rowp + bj * HALF) = xlane4(xs, pack8(acc[ai][bj][m][0] * rs, acc[ai][bj][m][1] * rs)); }
        }
    }
};
struct EpiUp { static constexpr bool PERM = true, AFTER_DRAIN = false, PREF = true;
    bf16_t* hid; const float* ssq; PG8_LAS float* tab;
    PG8_PREF_HOOKS
    __device__ __forceinline__ void operator()(const f32x4 (&acc)[2][2][4][2], const Unit& u, int wr, int wc, int fr, int fq, int buf) const {
        const unsigned z = launder0(), ln = fq * 16 + fr + z; const int xs = (int)(((ln & 3u) * 16u + (ln >> 2)) * 4u);
        const unsigned row0 = u.pm * BM + wr * 64 + fr + z, prow0 = u.pm * BM + wr * 64 + (ln >> 2), pcol0 = u.pn * BM + wc * 32 + 8 * (ln & 3u);
#pragma unroll
        for (int ai = 0; ai < 2; ++ai)
#pragma unroll
            for (int m = 0; m < 4; ++m) { const unsigned row = row0 + ai * HALF + m * 16; const float rs = tab[buf * 256 + (int)(row - u.pm * BM)]; bf16_t* rowp = hid + ((prow0 + ai * HALF + m * 16) * 4096u + pcol0);
#pragma unroll
                for (int bj = 0; bj < 2; ++bj) { f32x4 v0 = acc[ai][bj][m][0] * rs, v1 = acc[ai][bj][m][1] * rs;
#pragma unroll
                    for (int j = 0; j < 4; ++j) { const float a = fmaxf(v0[j], 0.f), b = fmaxf(v1[j], 0.f); v0[j] = a * a; v1[j] = b * b; }
                    *(u32x4*)(rowp + bj * HALF) = xlane4(xs, pack8(v0, v1)); } }
    }
};
struct EpiF32P { static constexpr bool PERM = true, AFTER_DRAIN = false, PREF = false;
    float* C; int ldc;
    __device__ __forceinline__ void operator()(const f32x4 (&acc)[2][2][4][2], const Unit& u, int wr, int wc, int fr, int fq) const {
        const unsigned row0 = u.pm * BM + wr * 64 + fr + launder0(), col0 = u.pn * BM + wc * 32 + 8 * fq;
#pragma unroll
        for (int ai = 0; ai < 2; ++ai)
#pragma unroll
            for (int m = 0; m < 4; ++m) { float* rowp = C + ((row0 + ai * HALF + m * 16) * (unsigned)ldc + col0);
#pragma unroll
                for (int bj = 0; bj < 2; ++bj) { *(f32x4*)(rowp + bj * HALF) = acc[ai][bj][m][0]; *(f32x4*)(rowp + bj * HALF + 4) = acc[ai][bj][m][1]; } }
    }
};
struct EpiPost { static constexpr bool PERM = true, AFTER_DRAIN = false, PREF = false;
    bf16_t* xb; float* out; const float* gain; float* ssq; unsigned long long* xg; unsigned tag; int xm; unsigned* tmo; PG8_LAS unsigned char* lds; int last;
    __device__ __forceinline__ void operator()(const f32x4 (&acc)[2][2][4][2], const Unit& u, int wr, int wc, int fr_in, int fq_in) const {
        const int rowbase = (int)launder0(), fr = fr_in + rowbase, fq = fq_in + rowbase;
        const int wid = wr * 4 + wc, lane = fq * 16 + fr;
        PG8_LAS float* P = (PG8_LAS float*)lds;
        PG8_LAS float* S = (PG8_LAS float*)(lds + 4096);
        PG8_LAS float* P2 = (PG8_LAS float*)(lds + 8192);
        const unsigned col0 = u.pn * BM + wc * 32 + 8 * fq;
        const unsigned lnp = (unsigned)lane; const int xs = (int)(((lnp & 3u) * 16u + (lnp >> 2)) * 4u), xr = (int)((unsigned)(fr * 4 + fq) * 4u);
        const unsigned pbase = (unsigned)(rowbase + u.pm * BM + wr * 64 + (int)(lnp >> 2)) * 1024u + u.pn * BM + wc * 32 + 8 * (lnp & 3u);
        u32x4 xw[2][4][2];
#pragma unroll
        for (int ai = 0; ai < 2; ++ai)
#pragma unroll
            for (int m = 0; m < 4; ++m) { const unsigned off = pbase + (unsigned)(ai * HALF + m * 16) * 1024u;
                xw[ai][m][0] = *(const u32x4*)(xb + off); xw[ai][m][1] = *(const u32x4*)(xb + off + HALF); }
        float sp[8];
#pragma unroll
        for (int ai = 0; ai < 2; ++ai)
#pragma unroll
            for (int m = 0; m < 4; ++m) { float sv = 0.f;
#pragma unroll
                for (int bj = 0; bj < 2; ++bj)
#pragma unroll
                    for (int n = 0; n < 2; ++n) { const f32x4 x = acc[ai][bj][m][n]; sv += (x[0] * x[0] + x[1] * x[1]) + (x[2] * x[2] + x[3] * x[3]); }
                sp[ai * 4 + m] = sv; }
#pragma unroll
        for (int i = 0; i < 8; ++i) sp[i] += __shfl_xor(sp[i], 16);
#pragma unroll
        for (int i = 0; i < 8; ++i) sp[i] += __shfl_xor(sp[i], 32);
        if (fq == 0) {
#pragma unroll
            for (int i = 0; i < 8; ++i) P[((i >> 2) * HALF + wr * 64 + (i & 3) * 16 + fr) * 4 + wc] = sp[i]; }
        asm volatile("s_waitcnt lgkmcnt(0)" ::: "memory"); __builtin_amdgcn_s_barrier(); asm volatile("" ::: "memory");
        const int row = wid * 32 + (lane & 31); const unsigned grow = (unsigned)(rowbase + u.pm * BM + row);
        if (lane < 32) { const f32x4 a = *(const PG8_LAS f32x4*)(P + row * 4); const float t = (a[0] + a[1]) + (a[2] + a[3]);
            const unsigned long long g = ((unsigned long long)tag << 32) | (unsigned long long)__float_as_uint(t); unsigned long long* gp = xg + (size_t)u.pn * SSQ_PLANE + grow;
            if (xm) __hip_atomic_store(gp, g, __ATOMIC_RELAXED, __HIP_MEMORY_SCOPE_WORKGROUP); else __hip_atomic_store(gp, g, __ATOMIC_RELAXED, __HIP_MEMORY_SCOPE_AGENT); }
        { const unsigned long long* gq = xg + (size_t)(2 * (lane >> 5)) * SSQ_PLANE + grow; float tsum; bool ok; unsigned spins = 0u;
            for (;;) {
                const unsigned long long ga = __hip_atomic_load(gq, __ATOMIC_RELAXED, __HIP_MEMORY_SCOPE_AGENT), gb = __hip_atomic_load(gq + SSQ_PLANE, __ATOMIC_RELAXED, __HIP_MEMORY_SCOPE_AGENT);
                ok = ((unsigned)(ga >> 32) == tag) && ((unsigned)(gb >> 32) == tag); tsum = __uint_as_float((unsigned)ga) + __uint_as_float((unsigned)gb);
                if (__builtin_amdgcn_ballot_w64(ok) == ~0ull) break;
                if (++spins > (1u << 20)) { if (lane == 0) __hip_atomic_store(tmo, 1u, __ATOMIC_RELAXED, __HIP_MEMORY_SCOPE_AGENT); break; }
                __builtin_amdgcn_s_sleep(1); }
            tsum += __shfl_xor(tsum, 32); const bool ok2 = ok && (bool)__shfl_xor((int)ok, 32);
            if (lane < 32) S[row] = ok2 ? 1.0f / sqrtf(tsum * (1.0f / 1024.0f) + RMS_EPS) : __builtin_nanf(""); }
        asm volatile("s_waitcnt lgkmcnt(0)" ::: "memory"); __builtin_amdgcn_s_barrier(); asm volatile("" ::: "memory");
        f32x4 gv[2][2];
#pragma unroll
        for (int bj = 0; bj < 2; ++bj) { gv[bj][0] = *(const f32x4*)(gain + col0 + bj * HALF); gv[bj][1] = *(const f32x4*)(gain + col0 + bj * HALF + 4); }
        float s2v[8];
#pragma unroll
        for (int ai = 0; ai < 2; ++ai)
#pragma unroll
            for (int m = 0; m < 4; ++m) { const int rl = ai * HALF + wr * 64 + m * 16 + fr; const float c = S[rl]; const unsigned off = (unsigned)(rowbase + u.pm * BM + rl) * 1024u + col0; float s2 = 0.f;
#pragma unroll
                for (int bj = 0; bj < 2; ++bj) { const u32x4 xv = xlane4(xr, xw[ai][m][bj]);
                    f32x4 x0, x1; x0[0] = __uint_as_float(xv.x << 16); x0[1] = __uint_as_float(xv.x & 0xffff0000u); x0[2] = __uint_as_float(xv.y << 16); x0[3] = __uint_as_float(xv.y & 0xffff0000u);
                    x1[0] = __uint_as_float(xv.z << 16); x1[1] = __uint_as_float(xv.z & 0xffff0000u); x1[2] = __uint_as_float(xv.w << 16); x1[3] = __uint_as_float(xv.w & 0xffff0000u);
                    x0 = x0 + acc[ai][bj][m][0] * gv[bj][0] * c; x1 = x1 + acc[ai][bj][m][1] * gv[bj][1] * c;
                    if (last) { *(f32x4*)(out + off + bj * HALF) = x0; *(f32x4*)(out + off + bj * HALF + 4) = x1; }
                    else { const u32x4 w = pack8(x0, x1); *(u32x4*)(xb + pbase + (unsigned)(ai * HALF + m * 16) * 1024u + bj * HALF) = xlane4(xs, w);
                        const float r0 = __uint_as_float(w.x << 16), r1 = __uint_as_float(w.x & 0xffff0000u), r2 = __uint_as_float(w.y << 16), r3 = __uint_as_float(w.y & 0xffff0000u);
                        const float r4 = __uint_as_float(w.z << 16), r5 = __uint_as_float(w.z & 0xffff0000u), r6 = __uint_as_float(w.w << 16), r7 = __uint_as_float(w.w & 0xffff0000u);
                        s2 += ((r0 * r0 + r1 * r1) + (r2 * r2 + r3 * r3)) + ((r4 * r4 + r5 * r5) + (r6 * r6 + r7 * r7)); } }
                s2v[ai * 4 + m] = s2; }
#pragma unroll
        for (int i = 0; i < 8; ++i) s2v[i] += __shfl_xor(s2v[i], 16);
#pragma unroll
        for (int i = 0; i < 8; ++i) s2v[i] += __shfl_xor(s2v[i], 32);
        if (fq == 0) {
#pragma unroll
            for (int i = 0; i < 8; ++i) P2[((i >> 2) * HALF + wr * 64 + (i & 3) * 16 + fr) * 4 + wc] = s2v[i]; }
        asm volatile("s_waitcnt lgkmcnt(0)" ::: "memory"); __builtin_amdgcn_s_barrier(); asm volatile("" ::: "memory");
        if (lane < 32) { const f32x4 a = *(const PG8_LAS f32x4*)(P2 + row * 4); ssq[(unsigned)u.pn * SSQ_PLANE + grow] = (a[0] + a[1]) + (a[2] + a[3]); }
    }
};
template <class Epi, class Sched, bool ALIGN_EPI = false, bool SP2 = false>
__device__ __forceinline__ void gemm_phase(PG8_LAS unsigned char* lds, const Gemm g, const Sched& S, const Epi& E, const int tid_in, unsigned long long& pr_k, unsigned long long& pr_e) {
    const int tid = tid_in, wid = __builtin_amdgcn_readfirstlane(tid >> 6), lane = tid & 63, wr = wid >> 2, wc = wid & 3, fr = lane & 15, fq = lane >> 4;
    const int K = g.K, nt = K / BK;
    unsigned voffA[2], voffB[2];
#pragma unroll
    for (int i = 0; i < 2; ++i) { int R, C; stage_rc(tid * 16 + i * 8192, R, C); const int Rb = Epi::PERM ? ((R & ~31) + perm32(R & 31)) : R;
        voffA[i] = (unsigned)(R * K + C) * 2u; voffB[i] = (unsigned)(Rb * K + C) * 2u; }
    const size_t kstep = (size_t)(BK * 2);
    const size_t hstep = (size_t)HALF * K * 2;
    const size_t tstep = 2 * hstep;
    const unsigned ldsw = (unsigned)wid * 1024u;
    const int aoff = lds_byte(wr * 64 + fr, fq * 8), boff = lds_byte(wc * 32 + fr, fq * 8);
#define PG8_SA(b, h) (((b) * 2 + (h)) * HTB)
#define PG8_SB(b, h) ((4 + (b) * 2 + (h)) * HTB)
#define PG8_STAGE(bufoff, gbase, voff) do { _Pragma("unroll") for (int _i = 0; _i < 2; ++_i) \
        __builtin_amdgcn_global_load_lds((const unsigned*)((const char*)(gbase) + (voff)[_i]), (PG8_LAS unsigned*)(lds + (bufoff) + ldsw + _i * 8192), 16, 0, 0); } while (0)
#define PG8_LDA(dst, b, h) do { _Pragma("unroll") for (int m = 0; m < 4; ++m) _Pragma("unroll") for (int k = 0; k < 2; ++k) dst[m][k] = *(const PG8_LAS bf16x8*)(lds + PG8_SA(b, h) + aoff + m * 2048 + k * 1024); } while (0)
#define PG8_LDB(dst, b, h) do { _Pragma("unroll") for (int n = 0; n < 2; ++n) _Pragma("unroll") for (int k = 0; k < 2; ++k) dst[n][k] = *(const PG8_LAS bf16x8*)(lds + PG8_SB(b, h) + boff + n * 2048 + k * 1024); } while (0)
#define PG8_MMA(ai, bj, At, Bt) do { __builtin_amdgcn_s_setprio(1); _Pragma("unroll") for (int m = 0; m < 4; ++m) _Pragma("unroll") for (int n = 0; n < 2; ++n) _Pragma("unroll") for (int k = 0; k < 2; ++k) \
        acc[ai][bj][m][n] = __builtin_amdgcn_mfma_f32_16x16x32_bf16(Bt[n][k], At[m][k], acc[ai][bj][m][n], 0, 0, 0); __builtin_amdgcn_s_setprio(0); } while (0)
#define PG8_WAIT_V(n) asm volatile("s_waitcnt vmcnt(" #n ")" ::: "memory")
#define PG8_WAIT_L(n) asm volatile("s_waitcnt lgkmcnt(" #n ")" ::: "memory")
#define PG8_BAR __builtin_amdgcn_s_barrier()
#define PG8_SCHED __builtin_amdgcn_sched_barrier(0)
    Unit cur, nxt; int ui = 0;
    if (!S.next(0, cur)) return;
    f32x4 acc[2][2][4][2];
#pragma unroll
    for (int a = 0; a < 2; ++a)
#pragma unroll
        for (int b = 0; b < 2; ++b)
#pragma unroll
            for (int m = 0; m < 4; ++m)
#pragma unroll
                for (int n = 0; n < 2; ++n) acc[a][b][m][n] = (f32x4){0.f, 0.f, 0.f, 0.f};
    bf16x8 At[4][2], B0[2][2], B1[2][2];
    const char* cA = (const char*)g.A + (size_t)cur.pm * tstep; const char* cB = (const char*)g.Bt + (size_t)cur.pn * tstep;
    S.a_ready(cur);
    if constexpr (Epi::PREF) { const f32x4 pv0 = E.pref_load(cur, tid); E.pref_store(pv0, 0, tid); }
    if constexpr (SP2) {
        PG8_STAGE(PG8_SB(0, 0), cB, voffB); PG8_STAGE(PG8_SB(0, 1), cB + hstep, voffB); PG8_STAGE(PG8_SA(0, 0), cA, voffA); PG8_STAGE(PG8_SA(0, 1), cA + hstep, voffA);
        if (wr == 1) PG8_BAR;
        PG8_WAIT_V(2); PG8_BAR;
        PG8_STAGE(PG8_SB(1, 0), cB + kstep, voffB); PG8_STAGE(PG8_SA(1, 0), cA + kstep, voffA); PG8_STAGE(PG8_SB(1, 1), cB + hstep + kstep, voffB);
        PG8_WAIT_V(6); PG8_BAR;
    } else {
        PG8_STAGE(PG8_SB(0, 0), cB, voffB); PG8_STAGE(PG8_SA(0, 0), cA, voffA); PG8_STAGE(PG8_SB(0, 1), cB + hstep, voffB); PG8_STAGE(PG8_SA(0, 1), cA + hstep, voffA);
        if (wr == 1) PG8_BAR;
        PG8_WAIT_V(4); PG8_BAR;
        PG8_STAGE(PG8_SB(1, 0), cB + kstep, voffB); PG8_STAGE(PG8_SA(1, 0), cA + kstep, voffA); PG8_STAGE(PG8_SB(1, 1), cB + hstep + kstep, voffB);
        PG8_WAIT_V(6); PG8_BAR;
    }
    for (;;) {
        const bool has_next = S.next(ui + 1, nxt);
        const char* nA = has_next ? (const char*)g.A + (size_t)nxt.pm * tstep : cA + (size_t)(nt - 2) * kstep; const char* nB = has_next ? (const char*)g.Bt + (size_t)nxt.pn * tstep : cB + (size_t)(nt - 2) * kstep;
        unsigned long long pt0 = 0ull; if (PROBE_CLASS == 20) pt0 = wall_clock64(); if (PROBE_CLASS == 50) pt0 = (unsigned long long)clock64();
        for (int t = 0; t < nt; t += 2) {
            const bool last = (t == nt - 2);
            const char* a1 = cA + (size_t)(t + 1) * kstep;
            const char* a2 = last ? nA : cA + (size_t)(t + 2) * kstep; const char* b2 = last ? nB : cB + (size_t)(t + 2) * kstep;
            const char* a3 = a2 + kstep; const char* b3 = b2 + kstep;
            if (last && has_next) S.a_ready(nxt);
            if constexpr (SP2) {
            PG8_LDB(B0, 0, 0); PG8_LDB(B1, 0, 1); PG8_SCHED; PG8_LDA(At, 0, 0); PG8_STAGE(PG8_SA(1, 1), a1 + hstep, voffA);
            PG8_WAIT_V(8); PG8_WAIT_L(0); PG8_BAR; PG8_MMA(0, 0, At, B0); PG8_MMA(0, 1, At, B1); PG8_BAR; PG8_SCHED;
            PG8_LDA(At, 0, 1); PG8_STAGE(PG8_SB(0, 0), b2, voffB); PG8_STAGE(PG8_SB(0, 1), b2 + hstep, voffB); PG8_STAGE(PG8_SA(0, 0), a2, voffA);
            PG8_WAIT_V(8); PG8_WAIT_L(0); PG8_BAR; PG8_MMA(1, 0, At, B0); PG8_MMA(1, 1, At, B1); PG8_BAR; PG8_SCHED;
            PG8_LDB(B0, 1, 0); PG8_LDB(B1, 1, 1); PG8_SCHED; PG8_LDA(At, 1, 0); PG8_STAGE(PG8_SA(0, 1), a2 + hstep, voffA);
            PG8_WAIT_V(8); PG8_WAIT_L(0); PG8_BAR; PG8_MMA(0, 0, At, B0); PG8_MMA(0, 1, At, B1); PG8_BAR; PG8_SCHED;
            PG8_LDA(At, 1, 1); PG8_STAGE(PG8_SB(1, 0), b3, voffB); PG8_STAGE(PG8_SB(1, 1), b3 + hstep, voffB); PG8_STAGE(PG8_SA(1, 0), a3, voffA);
            PG8_WAIT_V(8); PG8_WAIT_L(0); PG8_BAR; PG8_MMA(1, 0, At, B0); PG8_MMA(1, 1, At, B1); PG8_BAR; PG8_SCHED;
            } else {
            PG8_LDB(B0, 0, 0); PG8_SCHED; PG8_LDA(At, 0, 0); PG8_STAGE(PG8_SA(1, 1), a1 + hstep, voffA);
            PG8_WAIT_L(8); PG8_BAR; PG8_WAIT_L(0); PG8_MMA(0, 0, At, B0); PG8_BAR; PG8_SCHED;
            PG8_LDB(B1, 0, 1); PG8_STAGE(PG8_SB(0, 0), b2, voffB);
            PG8_BAR; PG8_WAIT_L(0); PG8_MMA(0, 1, At, B1); PG8_BAR;
            PG8_LDA(At, 0, 1); PG8_STAGE(PG8_SA(0, 0), a2, voffA);
            PG8_BAR; PG8_WAIT_L(0); PG8_MMA(1, 0, At, B0); PG8_BAR; PG8_SCHED;
            PG8_STAGE(PG8_SB(0, 1), b2 + hstep, voffB);
            PG8_WAIT_V(6); PG8_BAR; PG8_MMA(1, 1, At, B1); PG8_BAR;
            PG8_LDB(B0, 1, 0); PG8_SCHED; PG8_LDA(At, 1, 0); PG8_STAGE(PG8_SA(0, 1), a2 + hstep, voffA);
            PG8_WAIT_L(8); PG8_BAR; PG8_WAIT_L(0); PG8_MMA(0, 0, At, B0); PG8_BAR; PG8_SCHED;
            PG8_LDB(B1, 1, 1); PG8_STAGE(PG8_SB(1, 0), b3, voffB);
            PG8_BAR; PG8_WAIT_L(0); PG8_MMA(0, 1, At, B1); PG8_BAR;
            PG8_LDA(At, 1, 1); PG8_STAGE(PG8_SA(1, 0), a3, voffA);
            PG8_BAR; PG8_WAIT_L(0); PG8_MMA(1, 0, At, B0); PG8_BAR; PG8_SCHED;
            PG8_STAGE(PG8_SB(1, 1), b3 + hstep, voffB);
            PG8_WAIT_V(6); PG8_BAR; PG8_MMA(1, 1, At, B1); PG8_BAR;
            }
        }
        if (PROBE_CLASS == 20) pr_k += wall_clock64() - pt0;
        if (PROBE_CLASS == 50) pr_k += ((unsigned long long)clock64() - pt0) >> 8;
        if (PROBE_CLASS >= 21) pt0 = wall_clock64();
        if constexpr (ALIGN_EPI) { if (wr == 0) PG8_BAR; }
        if constexpr (!Epi::AFTER_DRAIN) {
            if constexpr (Epi::PREF) { f32x4 pvn = {0.f, 0.f, 0.f, 0.f}; if (has_next) pvn = E.pref_load(nxt, tid); E(acc, cur, wr, wc, fr, fq, ui & 1); if (has_next) E.pref_store(pvn, (ui + 1) & 1, tid); }
            else E(acc, cur, wr, wc, fr, fq);
            S.done(cur); }
        if (PROBE_CLASS >= 21) pr_e += wall_clock64() - pt0;
        if (!has_next) break;
#pragma unroll
        for (int a = 0; a < 2; ++a)
#pragma unroll
            for (int b = 0; b < 2; ++b)
#pragma unroll
                for (int m = 0; m < 4; ++m)
#pragma unroll
                    for (int n = 0; n < 2; ++n) acc[a][b][m][n] = (f32x4){0.f, 0.f, 0.f, 0.f};
        cur = nxt; cA = nA; cB = nB; ++ui;
        if constexpr (ALIGN_EPI) { if (wr == 1) PG8_BAR; }
    }
    unsigned long long pt1 = 0ull; if (PROBE_CLASS >= 21) pt1 = wall_clock64();
    PG8_WAIT_V(0);
    if constexpr (!ALIGN_EPI) { if (wr == 0) PG8_BAR; }
    PG8_BAR;
    if constexpr (Epi::AFTER_DRAIN) { E.fused(acc, cur, wr, wc, fr, fq, lds, wid, lane); S.done(cur); }
    if (PROBE_CLASS >= 21) pr_e += wall_clock64() - pt1;
#undef PG8_SA
#undef PG8_SB
#undef PG8_STAGE
#undef PG8_LDA
#undef PG8_LDB
#undef PG8_MMA
#undef PG8_WAIT_V
#undef PG8_WAIT_L
#undef PG8_BAR
#undef PG8_SCHED
}
}
#define GAS __attribute__((address_space(1)))
#define LAS __attribute__((address_space(3)))
typedef unsigned short bf16;
typedef unsigned v4u __attribute__((ext_vector_type(4)));
typedef float f32x4 __attribute__((ext_vector_type(4)));
typedef short bf16x8 __attribute__((ext_vector_type(8)));
typedef GAS unsigned gu32;
typedef GAS unsigned long long gu64;
#define RLX_AGENT __ATOMIC_RELAXED, __HIP_MEMORY_SCOPE_AGENT
#define LDS_WAIT() asm volatile("s_waitcnt lgkmcnt(0)" ::: "memory")
#define VM_WAIT() asm volatile("s_waitcnt vmcnt(0)" ::: "memory")
__device__ __forceinline__ unsigned long long rt() { return __builtin_amdgcn_s_memrealtime(); }
__device__ __forceinline__ unsigned f2bf(float f) { unsigned u = __builtin_bit_cast(unsigned, f); return (u + 0x7fffu + ((u >> 16) & 1u)) >> 16; }
__device__ __forceinline__ unsigned pk2(float lo, float hi) { return f2bf(lo) | (f2bf(hi) << 16); }

#define XB_TMO      128
#define XB_XCNT(j)  (256  + 64 * (j))
#define XB_XSUB(j)  (1280 + 64 * (j))
#define XB_XGEN(j)  (2304 + 64 * (j))
#define XB_TOP      3328
#define XB_TOPGEN   3392
#define XCD_BAR_WORDS 3456
#define XB_SPIN_CAP (1u << 18)

__device__ __forceinline__ unsigned xb_ld(unsigned* p)              { return __hip_atomic_load(p, __ATOMIC_RELAXED, __HIP_MEMORY_SCOPE_AGENT); }
__device__ __forceinline__ unsigned xb_add(unsigned* p, unsigned v) { return __hip_atomic_fetch_add(p, v, __ATOMIC_RELAXED, __HIP_MEMORY_SCOPE_AGENT); }
__device__ __forceinline__ unsigned xb_xcc_id() { return (unsigned)__builtin_amdgcn_s_getreg((3 << 11) | 20) & 0xFu; }
#define XB_SPIN(cond, bar) do { unsigned _sp = 0; while (cond) { __builtin_amdgcn_s_sleep(1); \
    if ((++_sp & 255u) == 0u) { if (xb_ld(&(bar)[XB_TMO])) break; if (_sp > XB_SPIN_CAP) { atomicAdd(&(bar)[XB_TMO], 1u); break; } } } } while (0)

__device__ __forceinline__ unsigned xb_lane_now() { unsigned z; asm volatile("v_mov_b32 %0, 0" : "=v"(z)); return __builtin_amdgcn_mbcnt_hi(~0u, __builtin_amdgcn_mbcnt_lo(~0u, z)); }
#define XB_T0(b) ((b).wv == 0u && xb_lane_now() == 0u)
struct XcdBarrier {
    unsigned wv;
    unsigned* bar; unsigned x;
    volatile LAS unsigned* st;
};

__device__ __forceinline__ XcdBarrier xcd_barrier_post(unsigned* bar, volatile LAS unsigned* st) {
    XcdBarrier b; b.bar = bar; b.x = xb_xcc_id(); b.st = st;
    if (threadIdx.x == 0) (void)xb_add(&bar[XB_XCNT(b.x)], 1u);
    return b;
}
__device__ __forceinline__ void xcd_barrier_complete(unsigned* bar, unsigned x, unsigned& nloc, unsigned& nx) {
    const unsigned G = gridDim.x * gridDim.y * gridDim.z;
    unsigned sum, cnt, mine, sp = 0u;
    for (;;) {
        sum = 0u; cnt = 0u; mine = 0u;
#pragma unroll
        for (unsigned j = 0; j < 16; ++j) { const unsigned c = xb_ld(&bar[XB_XCNT(j)]); sum += c; cnt += (c > 0u) ? 1u : 0u; mine = (j == x) ? c : mine; }
        if (sum == G) break;
        __builtin_amdgcn_s_sleep(1);
        if ((++sp & 255u) == 0u) { if (xb_ld(&bar[XB_TMO])) break; if (sp > XB_SPIN_CAP) { atomicAdd(&bar[XB_TMO], 1u); break; } }
    }
    nloc = mine > 0u ? mine : 1u; nx = cnt > 0u ? cnt : 1u;
}

__device__ __forceinline__ void xcd_barrier(const XcdBarrier& b) {
    asm volatile("s_waitcnt vmcnt(0)" ::: "memory");
    __syncthreads();
    if (XB_T0(b)) {
        unsigned* bar = b.bar;
        __builtin_amdgcn_s_waitcnt(0);
        unsigned nloc = b.st[0], nx = b.st[1];
        if (nloc == 0u) { xcd_barrier_complete(bar, b.x, nloc, nx); b.st[0] = nloc; b.st[1] = nx; }
        const unsigned old = xb_add(&bar[XB_XSUB(b.x)], 1u);
        const unsigned gen = old / nloc;
        if (old + 1u == (gen + 1u) * nloc) {
            __builtin_amdgcn_fence(__ATOMIC_RELEASE, "agent");
            asm volatile("s_waitcnt vmcnt(0)" ::: "memory");
            const unsigned og = xb_add(&bar[XB_TOP], 1u);
            const unsigned tg = og / nx;
            if (og + 1u == (tg + 1u) * nx) xb_add(&bar[XB_TOPGEN], 1u);
            else XB_SPIN(xb_ld(&bar[XB_TOPGEN]) == tg, bar);
            __builtin_amdgcn_fence(__ATOMIC_ACQUIRE, "agent");
            xb_add(&bar[XB_XGEN(b.x)], 1u);
            asm volatile("s_waitcnt vmcnt(0)" ::: "memory");
        } else {
            XB_SPIN(xb_ld(&bar[XB_XGEN(b.x)]) == gen, bar);
            __builtin_amdgcn_fence(__ATOMIC_ACQUIRE, "agent");
            asm volatile("s_waitcnt vmcnt(0)" ::: "memory");
        }
    }
    __syncthreads();
}
constexpr int NWAVES = 8, NT = 512;
constexpr int BATCH = 4, SEQ = 8192, D = 1024, FF = 4096, M = BATCH * SEQ, DEPTH = 4;
constexpr int NH = 4, DK = 128, DV = 256, CH = 128, NCH = SEQ / CH, NUNIT = BATCH * NH * NCH;
constexpr int MIN_COLS = 3080;
constexpr float EPS = 1e-6f, GATE_CAP = 15.0f;
constexpr size_t MiB = 1u << 20;
constexpr size_t WS_CTL = 0, CTL_ZERO_BYTES = 1 * MiB;
constexpr size_t WS_SSQ = 1 * MiB;
constexpr size_t WS_XCH = 1 * MiB + 512 * 1024;
constexpr size_t WS_IG = 2 * MiB, WS_LF = 2 * MiB + 512 * 1024;
constexpr size_t WS_BLAST = 3 * MiB, WS_MLOC = 3 * MiB + 128 * 1024, WS_MPREV = 3 * MiB + 256 * 1024;
constexpr size_t WS_NLOC = 3 * MiB + 512 * 1024, WS_NPREV = 4 * MiB;
constexpr size_t WS_WGT = 4 * MiB + 512 * 1024;
constexpr size_t WS_XCH2 = 5 * MiB;
constexpr size_t WS_XG = 6 * MiB;
constexpr size_t WS_W = 8 * MiB, W_LAYER = 24 * MiB, W_IN = 0, W_OUT = 6 * MiB, W_UP = 8 * MiB, W_DN = 16 * MiB;
constexpr size_t WS_XB = 104 * MiB;
constexpr size_t WS_S = 168 * MiB;
constexpr size_t WS_HID = WS_S;
constexpr size_t WS_Q = WS_S, WS_K = WS_S + 32 * MiB, WS_V = WS_S + 64 * MiB, WS_O = WS_S + 128 * MiB;
constexpr size_t WS_KVT = WS_S + 192 * MiB, WS_CT = WS_S + 256 * MiB;
constexpr size_t WS_BG = WS_S, WS_U = WS_S + 64 * MiB;
constexpr size_t WS_END = WS_S + 320 * MiB;
constexpr int CW_TMO = 0, CW_CODE = 1, CW_BAR = 4096, CW_SEAM = 16384;
constexpr int RING_OFF = 0, RING_BYTES = 131072, LDSCTL_OFF = RING_BYTES, MISC_OFF = LDSCTL_OFF + 320, LDS_BYTES = 147456;
constexpr int PH_PRO = 0, PH_PER_HL = 6, PH_END = 1 + 7 * PH_PER_HL + 5;

__device__ __forceinline__ int launder_i(int v) { asm volatile("" : "+v"(v)); return v; }
__device__ __forceinline__ float bf2f(bf16 b) { return __uint_as_float(((unsigned)b) << 16); }
__device__ __forceinline__ float wave_sum(float v) {
#pragma unroll
    for (int o = 1; o < 64; o <<= 1) v += __shfl_xor(v, o);
    return v;
}
struct P0Item { const float* W; const float* gain; bf16* WT; int ldw, src_col0, k0, K, dst_row0; float cscale; };
__device__ __forceinline__ void p0_load(const P0Item& I, float (&v)[32], int lane) {
#pragma unroll
    for (int i = 0; i < 32; ++i) { const int kk = 2 * i + (lane >> 5); v[i] = I.W[(size_t)(I.k0 + kk) * I.ldw + I.src_col0 + (lane & 31)]; }
}
__device__ __forceinline__ void p0_finish(const P0Item& I, const float (&v)[32], LAS float* scr, int lane) {
#pragma unroll
    for (int i = 0; i < 32; ++i) scr[(2 * i + (lane >> 5)) * 33 + (lane & 31)] = v[i];
    LDS_WAIT(); asm volatile("" ::: "memory");
    const int c = lane & 7;
    f32x4 g0 = {I.cscale, I.cscale, I.cscale, I.cscale}, g1 = g0;
    if (I.gain) { g0 = *(const GAS f32x4*)(I.gain + I.k0 + 8 * c) * I.cscale; g1 = *(const GAS f32x4*)(I.gain + I.k0 + 8 * c + 4) * I.cscale; }
#pragma unroll
    for (int j = 0; j < 4; ++j) { const int n = (lane >> 3) + 8 * j; const LAS float* s = scr + (8 * c) * 33 + n;
        v4u o; o.x = pk2(s[0 * 33] * g0[0], s[1 * 33] * g0[1]); o.y = pk2(s[2 * 33] * g0[2], s[3 * 33] * g0[3]); o.z = pk2(s[4 * 33] * g1[0], s[5 * 33] * g1[1]); o.w = pk2(s[6 * 33] * g1[2], s[7 * 33] * g1[3]);
        *(GAS v4u*)(I.WT + (size_t)(I.dst_row0 + n) * I.K + I.k0 + 8 * c) = o; }
    LDS_WAIT(); asm volatile("" ::: "memory");
}
struct Args { const float* in[11]; float* out; unsigned char* ws; int lo, hi, multi, pad; };

__device__ __forceinline__ void gates_naive(const bf16* xb, const float* Win, const float* g0, const float* bias, const float* ssq, float* ig, float* lf, int gtid, int gthreads) {
    for (int item = gtid; item < M * 8; item += gthreads) { const int row = item >> 3, j = item & 7; float s = 0.f;
        for (int k = 0; k < D; ++k) s += bf2f(xb[(size_t)row * D + k]) * g0[k] * Win[(size_t)k * MIN_COLS + 3072 + j];
        const float4 q = *(const float4*)(ssq + (size_t)row * 4); const float rs = 1.0f / sqrtf((q.x + q.y + q.z + q.w) * (1.0f / D) + EPS);
        float v = s * rs + bias[j]; v = GATE_CAP * tanhf(v / GATE_CAP);
        if (j < 4) ig[(size_t)row * 4 + j] = v; else lf[(size_t)row * 4 + (j - 4)] = fminf(v, 0.f) - log1pf(expf(-fabsf(v))); }
}
__device__ __forceinline__ void b1_naive(const bf16* kb, const bf16* vb, const float* ig, const float* lf, bf16* kvT, float* nloc, float* blast, float* mloc, LAS float* sm, int tid, int G) {
    LAS float* s_ig = sm; LAS float* s_lf = sm + 128; LAS float* s_b = sm + 256; LAS float* s_w = sm + 384;
    for (int u = blockIdx.x; u < NUNIT; u += G) {
        const int b = u >> 8, h = (u >> 6) & 3, c = u & 63; const size_t row0 = (size_t)b * SEQ + c * CH;
        if (tid < 128) { s_ig[tid] = ig[(row0 + tid) * 4 + h]; s_lf[tid] = lf[(row0 + tid) * 4 + h]; }
        __syncthreads();
        if (tid == 0) { float a = 0.f; for (int l = 0; l < 128; ++l) { a += s_lf[l]; s_b[l] = a; } const float bl = a; float mx = -INFINITY;
            for (int l = 0; l < 128; ++l) mx = fmaxf(mx, bl - s_b[l] + s_ig[l]);
            for (int l = 0; l < 128; ++l) s_w[l] = expf(bl - s_b[l] + s_ig[l] - mx);
            blast[u] = bl; mloc[u] = mx; }
        __syncthreads();
        const int d = tid & 127, eq = tid >> 7;
        for (int j = 0; j < 64; ++j) { const int e = eq + 4 * j; float s = 0.f;
            for (int l = 0; l < 128; ++l) s += s_w[l] * bf2f(kb[(row0 + l) * 512 + h * 128 + d]) * bf2f(vb[(row0 + l) * 1024 + h * 256 + e]);
            kvT[((size_t)u * 256 + e) * 128 + d] = (bf16)f2bf(s); }
        if (tid < 128) { float s = 0.f; for (int l = 0; l < 128; ++l) s += s_w[l] * bf2f(kb[(row0 + l) * 512 + h * 128 + tid]); nloc[(size_t)u * 128 + tid] = s; }
        __syncthreads();
    }
}
__device__ __forceinline__ void b2_naive(const bf16* kvT, bf16* CT, const float* nloc, float* nprev, const float* blast, const float* mloc, float* mprev, int gtid, int gthreads) {
    for (int idx = gtid; idx < 16 * 32768; idx += gthreads) { const int bh = idx >> 15, ed = idx & 32767; float m = 0.f, C = 0.f;
        for (int c = 0; c < NCH; ++c) { const int u = bh * 64 + c; const size_t off = (size_t)u * 32768 + ed; CT[off] = (bf16)f2bf(C);
            const float bl = blast[u], ml = mloc[u], mn = fmaxf(bl + m, ml), a = expf(bl + m - mn), s = expf(ml - mn); C = a * C + s * bf2f(kvT[off]); m = mn; } }
    for (int idx = gtid; idx < 16 * 128; idx += gthreads) { const int bh = idx >> 7, d = idx & 127; float m = 0.f, n = 0.f;
        for (int c = 0; c < NCH; ++c) { const int u = bh * 64 + c; nprev[(size_t)u * 128 + d] = n;
            const float bl = blast[u], ml = mloc[u], mn = fmaxf(bl + m, ml), a = expf(bl + m - mn), s = expf(ml - mn); n = a * n + s * nloc[(size_t)u * 128 + d]; m = mn; } }
    for (int idx = gtid; idx < 16; idx += gthreads) { float m = 0.f;
        for (int c = 0; c < NCH; ++c) { const int u = idx * 64 + c; mprev[u] = m; m = fmaxf(blast[u] + m, mloc[u]); } }
}
__device__ __forceinline__ void b3_naive(const bf16* qb, const bf16* kb, const bf16* vb, bf16* ob, const bf16* CT, const float* nprev, const float* mprev, const float* ig, const float* lf, const float* ghn,
                                         LAS float* sm, int tid, int G) {
    const int sb = tid >> 7, st = tid & 127;
    LAS float* s_a = sm + sb * 512; LAS float* s_P = s_a + 128; LAS float* s_red = s_a + 256; LAS float* s_misc = s_a + 384;
    const int niter = (M * NH) / (G * 4);
    for (int it = 0; it < niter; ++it) {
        const int item = (it * G + blockIdx.x) * 4 + sb; const int row = item >> 2, h = item & 3;
        const int b = row >> 13, tpos = row & 8191, c = tpos >> 7, tl = tpos & 127, unit = (b * 4 + h) * 64 + c; const size_t row0 = (size_t)row - tl;
        { float bs = 0.f; for (int l = 0; l <= st; ++l) bs += lf[(row0 + l) * 4 + h]; s_a[st] = ig[(row0 + st) * 4 + h] - bs; if (st == tl) s_misc[0] = bs; }
        __syncthreads();
        float cm = -INFINITY; for (int s = 0; s <= tl; ++s) cm = fmaxf(cm, s_a[s]);
        const float mp = mprev[unit], mm = fmaxf(cm, mp), bt = s_misc[0];
        const bf16* qrow = qb + (size_t)row * 512 + h * 128;
        { float dot = 0.f; const bf16* krow = kb + (row0 + st) * 512 + h * 128; for (int d = 0; d < 128; ++d) dot += bf2f(qrow[d]) * bf2f(krow[d]);
          s_P[st] = (st <= tl) ? dot * expf(s_a[st] - mm) : 0.f; }
        __syncthreads();
        const float inter = expf(mp - mm);
        float den = 0.f; for (int s = 0; s < 128; ++s) den += s_P[s];
        { float qn = 0.f; for (int d = 0; d < 128; ++d) qn += bf2f(qrow[d]) * nprev[(size_t)unit * 128 + d]; den += inter * qn; }
        const float dn = fmaxf(fabsf(den), expf(-(bt + mm)));
        float hv0, hv1;
        { const int e = st; float num = 0.f; for (int s = 0; s <= tl; ++s) num += s_P[s] * bf2f(vb[(row0 + s) * 1024 + h * 256 + e]);
          float qc = 0.f; const bf16* crow = CT + ((size_t)unit * 256 + e) * 128; for (int d = 0; d < 128; ++d) qc += bf2f(qrow[d]) * bf2f(crow[d]); hv0 = (num + inter * qc) / dn; }
        { const int e = st + 128; float num = 0.f; for (int s = 0; s <= tl; ++s) num += s_P[s] * bf2f(vb[(row0 + s) * 1024 + h * 256 + e]);
          float qc = 0.f; const bf16* crow = CT + ((size_t)unit * 256 + e) * 128; for (int d = 0; d < 128; ++d) qc += bf2f(qrow[d]) * bf2f(crow[d]); hv1 = (num + inter * qc) / dn; }
        s_red[st] = hv0 * hv0 + hv1 * hv1;
        __syncthreads();
        float ss = 0.f; for (int i = 0; i < 128; ++i) ss += s_red[i];
        const float rn = 1.0f / sqrtf(ss * (1.0f / 256.0f) + EPS);
        { const size_t oi = (size_t)row * 1024 + h * 256 + st; ob[oi] = (bf16)f2bf(hv0 * rn * ghn[h * 256 + st] * bf2f(ob[oi])); }
        { const size_t oi = (size_t)row * 1024 + h * 256 + st + 128; ob[oi] = (bf16)f2bf(hv1 * rn * ghn[h * 256 + st + 128] * bf2f(ob[oi])); }
        __syncthreads();
    }
}
__device__ __forceinline__ void conv_phase(bf16* bg, const bf16* ub, const float* wc, int ibase, int lt) {
    for (int li = lt; li < 131072; li += 32 * NT) { const int idx = ibase + li; const int r0 = (idx >> 7) * 4, ch0 = (idx & 127) * 8, t0 = r0 & (SEQ - 1);
        const v4u z = {0u, 0u, 0u, 0u};
        v4u uu[6], bb[4];
        uu[0] = t0 >= 2 ? *(const GAS v4u*)(ub + (size_t)(r0 - 2) * D + ch0) : z; uu[1] = t0 >= 2 ? *(const GAS v4u*)(ub + (size_t)(r0 - 1) * D + ch0) : z;
#pragma unroll
        for (int i = 0; i < 4; ++i) { uu[2 + i] = *(const GAS v4u*)(ub + (size_t)(r0 + i) * D + ch0); bb[i] = *(const GAS v4u*)(bg + (size_t)(r0 + i) * D + ch0); }
        const f32x4 w0a = *(const GAS f32x4*)(wc + ch0), w0b = *(const GAS f32x4*)(wc + ch0 + 4), w1a = *(const GAS f32x4*)(wc + D + ch0), w1b = *(const GAS f32x4*)(wc + D + ch0 + 4);
        const f32x4 w2a = *(const GAS f32x4*)(wc + 2 * D + ch0), w2b = *(const GAS f32x4*)(wc + 2 * D + ch0 + 4);
#pragma unroll
        for (int i = 0; i < 4; ++i) { v4u o;
#pragma unroll
            for (int j = 0; j < 4; ++j) { const float wl0 = j < 2 ? w0a[2 * j] : w0b[2 * j - 4], wh0 = j < 2 ? w0a[2 * j + 1] : w0b[2 * j - 3], wl1 = j < 2 ? w1a[2 * j] : w1b[2 * j - 4], wh1 = j < 2 ? w1a[2 * j + 1] : w1b[2 * j - 3];
                const float wl2 = j < 2 ? w2a[2 * j] : w2b[2 * j - 4], wh2 = j < 2 ? w2a[2 * j + 1] : w2b[2 * j - 3];
                const unsigned a = uu[2 + i][j], b1 = uu[1 + i][j], c2 = uu[i][j], gg = bb[i][j];
                const float y0 = __uint_as_float(gg << 16) * (wl0 * __uint_as_float(c2 << 16) + wl1 * __uint_as_float(b1 << 16) + wl2 * __uint_as_float(a << 16));
                const float y1 = __uint_as_float(gg & 0xffff0000u) * (wh0 * __uint_as_float(c2 & 0xffff0000u) + wh1 * __uint_as_float(b1 & 0xffff0000u) + wh2 * __uint_as_float(a & 0xffff0000u));
                o[j] = pk2(y0, y1); }
            *(GAS v4u*)(bg + (size_t)(r0 + i) * D + ch0) = o; }
    }
}
__device__ __forceinline__ void postnorm_naive(float* hout, bf16* xb, const float* g, float* ssq, bool last, int gw, int ngw, int lane) {
    for (int row = gw; row < M; row += ngw) {
        float* hr = hout + (size_t)row * D; bf16* xr = xb + (size_t)row * D;
        f32x4 hv[4]; float s = 0.f;
#pragma unroll
        for (int j = 0; j < 4; ++j) { hv[j] = *(const GAS f32x4*)(hr + 4 * lane + 256 * j); s += (hv[j][0] * hv[j][0] + hv[j][1] * hv[j][1]) + (hv[j][2] * hv[j][2] + hv[j][3] * hv[j][3]); }
        const float c = 1.0f / sqrtf(wave_sum(s) * (1.0f / D) + EPS); float s2 = 0.f;
#pragma unroll
        for (int j = 0; j < 4; ++j) { const int col = 4 * lane + 256 * j; const unsigned long long xw = *(const GAS unsigned long long*)(xr + col); const f32x4 gv = *(const GAS f32x4*)(g + col);
            const unsigned lo = (unsigned)xw, hi = (unsigned)(xw >> 32);
            f32x4 xn; xn[0] = __uint_as_float(lo << 16) + c * hv[j][0] * gv[0]; xn[1] = __uint_as_float(lo & 0xffff0000u) + c * hv[j][1] * gv[1];
            xn[2] = __uint_as_float(hi << 16) + c * hv[j][2] * gv[2]; xn[3] = __uint_as_float(hi & 0xffff0000u) + c * hv[j][3] * gv[3];
            const unsigned p0 = pk2(xn[0], xn[1]), p1 = pk2(xn[2], xn[3]);
            const float r0 = __uint_as_float(p0 << 16), r1 = __uint_as_float(p0 & 0xffff0000u), r2 = __uint_as_float(p1 << 16), r3 = __uint_as_float(p1 & 0xffff0000u);
            s2 += (r0 * r0 + r1 * r1) + (r2 * r2 + r3 * r3);
            *(GAS unsigned long long*)(xr + col) = (unsigned long long)p0 | ((unsigned long long)p1 << 32);
            if (last) *(GAS f32x4*)(hr + col) = xn; }
        s2 = wave_sum(s2);
        if (lane == 0) *(GAS f32x4*)(ssq + (size_t)row * 4) = (f32x4){s2, 0.f, 0.f, 0.f};
    }
}


typedef short s16x4 __attribute__((ext_vector_type(4)));
typedef short v4i16_t __attribute__((ext_vector_type(4)));
typedef unsigned u32x2v __attribute__((ext_vector_type(2)));
__device__ __forceinline__ s16x4 tr16(LAS const unsigned char* p) { return __builtin_bit_cast(s16x4, __builtin_amdgcn_ds_read_tr16_b64_v4i16((LAS v4i16_t*)p)); }
__device__ __forceinline__ bf16x8 cat8(s16x4 lo, s16x4 hi) { return (bf16x8){lo[0], lo[1], lo[2], lo[3], hi[0], hi[1], hi[2], hi[3]}; }
#define MFMA16(a, b, c) __builtin_amdgcn_mfma_f32_16x16x32_bf16(a, b, c, 0, 0, 0)
constexpr int KP = 288, VP = 544;
constexpr int LDS_KS = 0, LDS_VS = 128 * KP, LDS_SC = LDS_VS + 128 * VP;
static_assert(LDS_SC + 2048 + 4096 <= RING_BYTES, "mLSTM LDS map");
__device__ __forceinline__ float wave_incl_sum(float s, int lane) {
#pragma unroll
    for (int o = 1; o < 64; o <<= 1) { const float t = __shfl_up(s, o); if (lane >= o) s += t; }
    return s;
}
__device__ __forceinline__ float wave_incl_max(float s, int lane) {
#pragma unroll
    for (int o = 1; o < 64; o <<= 1) { const float t = __shfl_up(s, o); if (lane >= o) s = fmaxf(s, t); }
    return s;
}
__device__ __forceinline__ float wave_max(float v) {
#pragma unroll
    for (int o = 1; o < 64; o <<= 1) v = fmaxf(v, __shfl_xor(v, o));
    return v;
}
__device__ __forceinline__ void stage_load(const bf16* kbase, const bf16* vbase, v4u (&tk)[4], v4u (&tv)[8], int tl) {
    const unsigned ko = (unsigned)((tl >> 4) * 512 + (tl & 15) * 8), vo = (unsigned)((tl >> 5) * 1024 + (tl & 31) * 8);
#pragma unroll
    for (int i = 0; i < 4; ++i) tk[i] = *(const GAS v4u*)(kbase + (ko + (unsigned)(i * 32 * 512)));
#pragma unroll
    for (int i = 0; i < 8; ++i) tv[i] = *(const GAS v4u*)(vbase + (vo + (unsigned)(i * 16 * 1024)));
}
template <bool SCALE> __device__ __forceinline__ void stage_store(v4u (&tk)[4], const v4u (&tv)[8], LAS unsigned char* L, const LAS float* s_w, int tl) {
    const int r4 = tl >> 4, c8k = tl & 15, r5 = tl >> 5, c8v = tl & 31;
#pragma unroll
    for (int i = 0; i < 4; ++i) { const int r = r4 + 32 * i;
        if (SCALE) { const float w = s_w[r];
#pragma unroll
            for (int j = 0; j < 4; ++j) tk[i][j] = pk2(__uint_as_float(tk[i][j] << 16) * w, __uint_as_float(tk[i][j] & 0xffff0000u) * w); }
        *(LAS v4u*)(L + LDS_KS + r * KP + c8k * 16) = tk[i]; }
#pragma unroll
    for (int i = 0; i < 8; ++i) *(LAS v4u*)(L + LDS_VS + (r5 + 16 * i) * VP + c8v * 16) = tv[i];
}
__device__ __forceinline__ int mixer_unit(int vc, int i) { const int jj = (vc >> 3) * 4 + i; return (((vc & 7) >> 1) * 4 + (jj & 3)) * 64 + 32 * (vc & 1) + (jj >> 2); }
__device__ __forceinline__ void b1_fast(const bf16* kb, const bf16* vb, const float* ig, const float* lf, bf16* kvT, float* nloc, float* blast, float* mloc, LAS unsigned char* L, int tid, int vc) {
    LAS float* s_w = (LAS float*)(L + LDS_SC);
    for (int ui = 0; ui < 4; ++ui) { const int u = mixer_unit(vc, ui);
        const int tl = launder_i(tid);
        const int lane = tl & 63, wave = __builtin_amdgcn_readfirstlane(tl >> 6), g = lane >> 4, c16 = lane & 15, q = (lane >> 2) & 3, p = lane & 3;
        const int b = u >> 8, h = (u >> 6) & 3, c = u & 63; const size_t row0 = (size_t)b * SEQ + c * CH;
        v4u tk[4], tv[8];
        stage_load(kb + row0 * 512 + h * 128, vb + row0 * 1024 + h * 256, tk, tv, tl);
        if (wave == 0) {
            const float* lfp = lf + row0 * 4 + h; const float* igp = ig + row0 * 4 + h;
            const float x0 = lfp[8 * lane], x1 = lfp[8 * lane + 4], i0 = igp[8 * lane], i1 = igp[8 * lane + 4];
            const float sc = wave_incl_sum(x0 + x1, lane), ex = sc - (x0 + x1), b0 = ex + x0, b1 = sc, bl = __int_as_float(__builtin_amdgcn_readlane(__float_as_int(sc), 63));
            const float lw0 = bl - b0 + i0, lw1 = bl - b1 + i1, mx = wave_max(fmaxf(lw0, lw1));
            s_w[2 * lane] = expf(lw0 - mx); s_w[2 * lane + 1] = expf(lw1 - mx);
            if (lane == 0) { blast[u * 32] = bl; mloc[u * 32] = mx; }
        }
        __syncthreads();
        stage_store<true>(tk, tv, L, s_w, tl);
        __syncthreads();
        const short one = (c16 == 0) ? (short)0x3F80 : (short)0; const bf16x8 ones = {one, one, one, one, one, one, one, one};
        f32x4 acc[8][2], accn = {0.f, 0.f, 0.f, 0.f};
#pragma unroll
        for (int dt = 0; dt < 8; ++dt) { acc[dt][0] = (f32x4){0.f, 0.f, 0.f, 0.f}; acc[dt][1] = (f32x4){0.f, 0.f, 0.f, 0.f}; }
        const LAS unsigned char* vbp = L + LDS_VS + (4 * g + q) * VP + (32 * wave + 4 * p) * 2;
        const LAS unsigned char* kbp = L + LDS_KS + (4 * g + q) * KP + (4 * p) * 2;
#pragma unroll
        for (int ks = 0; ks < 4; ++ks) { bf16x8 vf[2];
#pragma unroll
            for (int et = 0; et < 2; ++et) { const LAS unsigned char* bp = vbp + 32 * ks * VP + 32 * et; vf[et] = cat8(tr16(bp), tr16(bp + 16 * VP)); }
#pragma unroll
            for (int dt = 0; dt < 8; ++dt) { const LAS unsigned char* bp = kbp + 32 * ks * KP + 32 * dt; const bf16x8 kf = cat8(tr16(bp), tr16(bp + 16 * KP));
                acc[dt][0] = MFMA16(kf, vf[0], acc[dt][0]); acc[dt][1] = MFMA16(kf, vf[1], acc[dt][1]); }
        }
#pragma unroll
        for (int ks = 0; ks < 4; ++ks) { const LAS unsigned char* bp = kbp + 32 * ks * KP + 32 * wave; accn = MFMA16(cat8(tr16(bp), tr16(bp + 16 * KP)), ones, accn); }
        bf16* kvu = kvT + (size_t)u * 32768; const unsigned so = (unsigned)((8 * wave * 64 + 16 * (g >> 1) + c16) * 8 + 4 * (g & 1));
#pragma unroll
        for (int dt = 0; dt < 8; ++dt)
#pragma unroll
            for (int et = 0; et < 2; ++et) { u32x2v w; w.x = pk2(acc[dt][et][0], acc[dt][et][1]); w.y = pk2(acc[dt][et][2], acc[dt][et][3]);
                *(GAS u32x2v*)(kvu + (so + (unsigned)(((et * 4 + (dt >> 1)) * 64 + 32 * (dt & 1)) * 8))) = w; }
        if (c16 == 0) *(GAS f32x4*)(nloc + (size_t)u * 128 + 16 * wave + 4 * g) = accn;
        __syncthreads();
    }
}
__device__ __forceinline__ void b2_fast(const bf16* kvT, bf16* CT, const float* nloc, bf16* NPB, const float* blast, const float* mloc, float* mprev, LAS unsigned char* L, int tid, int item0, int G) {
    LAS float* s_a = (LAS float*)L; LAS float* s_s = s_a + 64; LAS float* s_bl = s_a + 128; LAS float* s_ml = s_a + 192;
    for (int item = item0; item < 256; item += G) { const int bh = item >> 4, part = item & 15;
        if (tid < 64) {
            const float bl = blast[(bh * 64 + tid) * 32], ml = mloc[(bh * 64 + tid) * 32]; float A = bl, B = ml;
#pragma unroll
            for (int o = 1; o < 64; o <<= 1) { const float Ap = __shfl_up(A, o), Bp = __shfl_up(B, o); if (tid >= o) { B = fmaxf(Bp + A, B); A = Ap + A; } }
            const float mn = fmaxf(A, B);
            float m = __shfl_up(mn, 1); if (tid == 0) m = 0.f;
            s_a[tid] = expf(bl + m - mn); s_s[tid] = expf(ml - mn); if (part == 0) mprev[bh * 64 + tid] = m; }
        __syncthreads();
        if (tid < 256) {
            const size_t off = (size_t)bh * 64 * 32768 + part * 2048 + tid * 8;
            float C[8];
#pragma unroll
            for (int j = 0; j < 8; ++j) C[j] = 0.f;
            for (int c0 = 0; c0 < NCH; c0 += 16) {
                v4u kvb[16];
#pragma unroll
                for (int i = 0; i < 16; ++i) kvb[i] = *(const GAS v4u*)(kvT + off + (size_t)(c0 + i) * 32768);
#pragma unroll
                for (int i = 0; i < 16; ++i) { const int c = c0 + i; const v4u kv = kvb[i];
                    v4u o; o.x = pk2(C[0], C[1]); o.y = pk2(C[2], C[3]); o.z = pk2(C[4], C[5]); o.w = pk2(C[6], C[7]); *(GAS v4u*)(CT + off + (size_t)c * 32768) = o;
                    const float a = s_a[c], sv = s_s[c];
#pragma unroll
                    for (int j = 0; j < 4; ++j) { C[2 * j] = a * C[2 * j] + sv * __uint_as_float(kv[j] << 16); C[2 * j + 1] = a * C[2 * j + 1] + sv * __uint_as_float(kv[j] & 0xffff0000u); } } }
        } else if (part == 0 && tid < 384) { const int d = tid - 256; float n = 0.f;
            for (int c0 = 0; c0 < NCH; c0 += 16) { float nl[16];
#pragma unroll
                for (int i = 0; i < 16; ++i) nl[i] = nloc[(size_t)(bh * 64 + c0 + i) * 128 + d];
#pragma unroll
                for (int i = 0; i < 16; ++i) { const int c = c0 + i; NPB[(size_t)(bh * 64 + c) * 128 + d] = (bf16)f2bf(n); n = s_a[c] * n + s_s[c] * nl[i]; } } }
        __syncthreads();
    }
}
__device__ __forceinline__ void b3_fast(const bf16* qb, const bf16* kb, const bf16* vb, bf16* ob, const bf16* CT, const bf16* NPB, const float* mprev, const float* ig, const float* lf, const float* ghn,
                                        LAS unsigned char* L, int tid, int vc) {
    LAS float* s_a = (LAS float*)(L + LDS_SC); LAS float* s_mm = s_a + 128; LAS float* s_bm = s_a + 256;
    LAS float* s_gh = (LAS float*)(L + LDS_SC + 2048);
    for (int i = tid; i < 256; i += NT) *(LAS f32x4*)(s_gh + 4 * i) = *(const GAS f32x4*)(ghn + 4 * i);
    for (int ui = 3; ui >= 0; --ui) { const int u = mixer_unit(vc, ui);
        const int tl = launder_i(tid);
        const int lane = tl & 63, wave = __builtin_amdgcn_readfirstlane(tl >> 6), g = lane >> 4, c16 = lane & 15, q = (lane >> 2) & 3, p = lane & 3;
        const int b = u >> 8, h = (u >> 6) & 3, c = u & 63; const size_t row0 = (size_t)b * SEQ + c * CH;
        const float mp = mprev[u];
        v4u tk[4], tv[8];
        stage_load(kb + row0 * 512 + h * 128, vb + row0 * 1024 + h * 256, tk, tv, tl);
        const int t = 16 * wave + c16;
        bf16x8 qf[4];
        { const bf16* qbase = qb + row0 * 512 + h * 128; const unsigned qo = (unsigned)(t * 512 + 8 * g);
#pragma unroll
          for (int ks = 0; ks < 4; ++ks) qf[ks] = *(const GAS bf16x8*)(qbase + (qo + 32u * ks)); }
        const bf16* ctb = CT + (size_t)u * 32768; const unsigned coff = (unsigned)(lane * 8);
        bf16x8 cf[3][4];
#pragma unroll
        for (int pe = 0; pe < 2; ++pe)
#pragma unroll
            for (int ks = 0; ks < 4; ++ks) cf[pe][ks] = *(const GAS bf16x8*)(ctb + (coff + (unsigned)((pe * 4 + ks) * 512)));
        if (wave == 0) {
            const float* lfp = lf + row0 * 4 + h; const float* igp = ig + row0 * 4 + h;
            const float x0 = lfp[8 * lane], x1 = lfp[8 * lane + 4], i0 = igp[8 * lane], i1 = igp[8 * lane + 4];
            const float sc = wave_incl_sum(x0 + x1, lane), ex = sc - (x0 + x1), b0 = ex + x0, b1 = sc;
            const float a0 = i0 - b0, a1 = i1 - b1, cmx = wave_incl_max(fmaxf(a0, a1), lane);
            float pe = __shfl_up(cmx, 1); if (lane == 0) pe = -INFINITY;
            const float mm0 = fmaxf(fmaxf(pe, a0), mp), mm1 = fmaxf(cmx, mp);
            s_a[2 * lane] = a0; s_a[2 * lane + 1] = a1; s_mm[2 * lane] = mm0; s_mm[2 * lane + 1] = mm1; s_bm[2 * lane] = b0 + mm0; s_bm[2 * lane + 1] = b1 + mm1;
        }
        stage_store<false>(tk, tv, L, nullptr, tl);
        __syncthreads();
        const float mm_t = s_mm[t], bm_t = s_bm[t], inter_t = expf(mp - mm_t);
        const short one = (c16 == 0) ? (short)0x3F80 : (short)0; const bf16x8 ones = {one, one, one, one, one, one, one, one};
        f32x4 acc[16], accn = {0.f, 0.f, 0.f, 0.f};
#pragma unroll
        for (int et = 0; et < 16; ++et) acc[et] = (f32x4){0.f, 0.f, 0.f, 0.f};
#pragma unroll
        for (int et = 0; et < 16; ++et) {
            if (et + 2 < 16) {
#pragma unroll
                for (int ks = 0; ks < 4; ++ks) cf[(et + 2) % 3][ks] = *(const GAS bf16x8*)(ctb + (coff + (unsigned)(((et + 2) * 4 + ks) * 512))); }
#pragma unroll
            for (int ks = 0; ks < 4; ++ks) acc[et] = MFMA16(cf[et % 3][ks], qf[ks], acc[et]);
        }
        bf16* obase = ob + (row0 + 16 * wave) * 1024 + h * 256; const unsigned oo = (unsigned)((lane >> 5) * 1024 + (lane & 31) * 8);
        v4u sg[8];
#pragma unroll
        for (int i = 0; i < 8; ++i) sg[i] = *(const GAS v4u*)(obase + (oo + 2048u * i));
        { const bf16* npb = NPB + (size_t)u * 128;
#pragma unroll
          for (int ks = 0; ks < 4; ++ks) { bf16x8 nf = *(const GAS bf16x8*)(npb + (32 * ks + 8 * g)); if (c16 != 0) nf = (bf16x8){0, 0, 0, 0, 0, 0, 0, 0}; accn = MFMA16(nf, qf[ks], accn); } }
#pragma unroll
        for (int et = 0; et < 16; ++et) acc[et] = acc[et] * inter_t;
        accn = accn * inter_t;
        const LAS unsigned char* kbp = L + LDS_KS + c16 * KP + 16 * g;
        const LAS unsigned char* vbp = L + LDS_VS + (4 * g + q) * VP + 8 * p;
        for (int ss = 0; ss <= (wave >> 1); ++ss) { const int s0 = 32 * ss;
            f32x4 X0 = {0.f, 0.f, 0.f, 0.f}, X1 = {0.f, 0.f, 0.f, 0.f};
#pragma unroll
            for (int ks = 0; ks < 4; ++ks) { const bf16x8 k0f = *(const LAS bf16x8*)(kbp + s0 * KP + 64 * ks), k1f = *(const LAS bf16x8*)(kbp + (s0 + 16) * KP + 64 * ks);
                X0 = MFMA16(k0f, qf[ks], X0); X1 = MFMA16(k1f, qf[ks], X1); }
            const f32x4 a40 = *(const LAS f32x4*)(s_a + s0 + 4 * g), a41 = *(const LAS f32x4*)(s_a + s0 + 16 + 4 * g);
            float P0[4], P1[4];
#pragma unroll
            for (int r = 0; r < 4; ++r) { const int s = s0 + 4 * g + r; P0[r] = (s <= t) ? X0[r] * __expf(a40[r] - mm_t) : 0.f; P1[r] = (s + 16 <= t) ? X1[r] * __expf(a41[r] - mm_t) : 0.f;   }
            v4u pw; pw.x = pk2(P0[0], P0[1]); pw.y = pk2(P0[2], P0[3]); pw.z = pk2(P1[0], P1[1]); pw.w = pk2(P1[2], P1[3]);
            const bf16x8 pf = __builtin_bit_cast(bf16x8, pw);
#pragma unroll
            for (int et = 0; et < 16; ++et) { const LAS unsigned char* bp = vbp + s0 * VP + 32 * et; const bf16x8 vf = cat8(tr16(bp), tr16(bp + 16 * VP)); acc[et] = MFMA16(vf, pf, acc[et]); }
            accn = MFMA16(ones, pf, accn);
        }
        const float den = __shfl(accn[0], c16), dn = fmaxf(fabsf(den), expf(-bm_t)), inv = 1.0f / dn;
        float ssq = 0.f;
#pragma unroll
        for (int et = 0; et < 16; ++et) { acc[et] = acc[et] * inv; ssq += (acc[et][0] * acc[et][0] + acc[et][1] * acc[et][1]) + (acc[et][2] * acc[et][2] + acc[et][3] * acc[et][3]); }
        ssq += __shfl_xor(ssq, 16); ssq += __shfl_xor(ssq, 32);
        const float rn = 1.0f / sqrtf(ssq * (1.0f / 256.0f) + EPS);
        __syncthreads();
        LAS unsigned char* ost = L + LDS_VS + wave * (16 * 528);
#pragma unroll
        for (int et = 0; et < 16; ++et) { const f32x4 gh = *(const LAS f32x4*)(s_gh + h * 256 + 16 * et + 4 * g);
            u32x2v w; w.x = pk2(acc[et][0] * rn * gh[0], acc[et][1] * rn * gh[1]); w.y = pk2(acc[et][2] * rn * gh[2], acc[et][3] * rn * gh[3]);
            *(LAS u32x2v*)(ost + c16 * 528 + (16 * et + 4 * g) * 2) = w; }
        LDS_WAIT(); asm volatile("" ::: "memory");
#pragma unroll
        for (int i = 0; i < 8; ++i) { const v4u hv = *(const LAS v4u*)(ost + ((lane >> 5) + 2 * i) * 528 + (lane & 31) * 16); v4u o;
#pragma unroll
            for (int j = 0; j < 4; ++j) o[j] = pk2(__uint_as_float(hv[j] << 16) * __uint_as_float(sg[i][j] << 16), __uint_as_float(hv[j] & 0xffff0000u) * __uint_as_float(sg[i][j] & 0xffff0000u));
            *(GAS v4u*)(obase + (oo + 2048u * i)) = o; }
        __syncthreads();
    }
}
__device__ __forceinline__ void gates_fast(const bf16* xb, const bf16* wgT, const float* bias, const float* ssq, float* ig, float* lf, int gw, int ngw, int lane) {
    const int g = lane >> 4, c16 = lane & 15;
    for (int tile = gw; tile < M / 16; tile += ngw) { const size_t row = (size_t)tile * 16 + c16; f32x4 acc = {0.f, 0.f, 0.f, 0.f};
#pragma unroll 8
        for (int ks = 0; ks < 32; ++ks) { const bf16x8 wf = *(const GAS bf16x8*)(wgT + c16 * D + 32 * ks + 8 * g), xf = *(const GAS bf16x8*)(xb + row * D + 32 * ks + 8 * g); acc = MFMA16(wf, xf, acc); }
        const float rs = 1.0f / sqrtf(((ssq[row] + ssq[M + row]) + (ssq[2 * M + row] + ssq[3 * M + row])) * (1.0f / D) + EPS);
        if (g < 2) { f32x4 o;
#pragma unroll
            for (int r = 0; r < 4; ++r) { float v = acc[r] * rs + bias[4 * g + r]; v = GATE_CAP * tanhf(v * (1.0f / GATE_CAP)); o[r] = (g == 0) ? v : (fminf(v, 0.f) - log1pf(expf(-fabsf(v)))); }
            *(GAS f32x4*)((g == 0 ? ig : lf) + row * 4) = o; }
    }
}

#define XB_LSUB(j)  (3520 + 64 * (j))
#define XB_LGEN(j)  (4544 + 64 * (j))
__device__ __forceinline__ XcdBarrier xcd_barrier_post_rank(unsigned* bar, volatile LAS unsigned* st, volatile LAS unsigned* rank_word, unsigned wv) {
    XcdBarrier b; b.wv = wv; b.bar = bar; b.x = xb_xcc_id(); b.st = st;
    if (XB_T0(b)) *rank_word = xb_add(&bar[XB_XCNT(b.x)], 1u);
    return b;
}
#define XB_LSLOT(j) (8192 + 32 * (j))
__device__ __forceinline__ void xcd_local_barrier(const XcdBarrier& b, volatile LAS unsigned* rankw, volatile LAS unsigned* genw) {
    asm volatile("s_waitcnt vmcnt(0)" ::: "memory");
    __syncthreads();
    if (b.wv == 0u) {
        unsigned* line = b.bar + XB_LSLOT(b.x); const unsigned l = xb_lane_now();
        const unsigned rank = (unsigned)__builtin_amdgcn_readfirstlane((int)*rankw), gen = (unsigned)__builtin_amdgcn_readfirstlane((int)*genw) + 1u;
        __builtin_amdgcn_s_waitcnt(0);
        if (l == 0u) { *genw = gen; __hip_atomic_store(line + rank, gen, __ATOMIC_RELAXED, __HIP_MEMORY_SCOPE_WORKGROUP); }
        unsigned sp = 0u;
        for (;;) {
            const unsigned v = __hip_atomic_load(line + (l & 31u), __ATOMIC_RELAXED, __HIP_MEMORY_SCOPE_AGENT);
            if (__builtin_amdgcn_ballot_w64((int)(v - gen) >= 0) == ~0ull) break;
            __builtin_amdgcn_s_sleep(1);
            if ((++sp & 255u) == 0u) { if (xb_ld(&b.bar[XB_TMO])) break; if (sp > XB_SPIN_CAP) { atomicAdd(&b.bar[XB_TMO], 1u); break; } } }
        __builtin_amdgcn_fence(__ATOMIC_ACQUIRE, "agent");
        asm volatile("s_waitcnt vmcnt(0)" ::: "memory");
    }
    __syncthreads();
}
#define XB_GSLOT(j) (8448 + 32 * (j))
#define XB_GREL(j)  (8704 + 32 * (j))
#define XB_WDONE    9728
#define XB_PTOP(p)  (9216 + 64 * (p))
#define XB_PGEN(p)  (9472 + 64 * (p))
__device__ __forceinline__ void xcd_pair_barrier(const XcdBarrier& b, volatile LAS unsigned* rankw, volatile LAS unsigned* genw) {
    asm volatile("s_waitcnt vmcnt(0)" ::: "memory");
    __syncthreads();
    if (b.wv == 0u) {
        unsigned* bar = b.bar; unsigned* line = bar + XB_GSLOT(b.x); unsigned* rel = bar + XB_GREL(b.x); const unsigned l = xb_lane_now();
        const unsigned rank = (unsigned)__builtin_amdgcn_readfirstlane((int)*rankw), gen = (unsigned)__builtin_amdgcn_readfirstlane((int)*genw) + 1u;
        __builtin_amdgcn_s_waitcnt(0);
        if (l == 0u) { *genw = gen; __hip_atomic_store(line + rank, gen, __ATOMIC_RELAXED, __HIP_MEMORY_SCOPE_WORKGROUP); }
        unsigned sp = 0u;
        if (rank == 0u) {
            for (;;) {
                const unsigned v = __hip_atomic_load(line + (l & 31u), __ATOMIC_RELAXED, __HIP_MEMORY_SCOPE_AGENT);
                if (__builtin_amdgcn_ballot_w64((int)(v - gen) >= 0) == ~0ull) break;
                __builtin_amdgcn_s_sleep(1);
                if ((++sp & 255u) == 0u) { if (xb_ld(&bar[XB_TMO])) break; if (sp > XB_SPIN_CAP) { atomicAdd(&bar[XB_TMO], 1u); break; } } }
            __builtin_amdgcn_fence(__ATOMIC_RELEASE, "agent");
            asm volatile("s_waitcnt vmcnt(0)" ::: "memory");
            if (l == 0u) { const unsigned pr = b.x >> 1, og = xb_add(&bar[XB_PTOP(pr)], 1u), tg = og / 2u;
                if (og + 1u == (tg + 1u) * 2u) xb_add(&bar[XB_PGEN(pr)], 1u);
                else XB_SPIN(xb_ld(&bar[XB_PGEN(pr)]) == tg, bar); }
            __builtin_amdgcn_fence(__ATOMIC_ACQUIRE, "agent");
            if (l == 0u) __hip_atomic_store(rel, gen, __ATOMIC_RELAXED, __HIP_MEMORY_SCOPE_WORKGROUP);
            asm volatile("s_waitcnt vmcnt(0)" ::: "memory");
        } else {
            for (;;) {
                const unsigned v = __hip_atomic_load(rel, __ATOMIC_RELAXED, __HIP_MEMORY_SCOPE_AGENT);
                if ((int)((unsigned)__builtin_amdgcn_readfirstlane((int)v) - gen) >= 0) break;
                __builtin_amdgcn_s_sleep(1);
                if ((++sp & 255u) == 0u) { if (xb_ld(&bar[XB_TMO])) break; if (sp > XB_SPIN_CAP) { atomicAdd(&bar[XB_TMO], 1u); break; } } }
            __builtin_amdgcn_fence(__ATOMIC_ACQUIRE, "agent");
            asm volatile("s_waitcnt vmcnt(0)" ::: "memory");
        }
    }
    __syncthreads();
}
#define BSEL_() ({ int t_ = bsel; asm volatile("" : "+s"(t_)); (size_t)t_; })
#define SP_(OFFC, OFFB, ROWB) ((bf16*)(ws + WS_S + (xmode ? (size_t)(OFFB) : (size_t)(OFFC)) + BSEL_() * (size_t)(80 * MiB - (size_t)(ROWB))))
#define hid SP_(0, 0, (size_t)SEQ * FF * 2)
#define qb  SP_(0, 0, (size_t)SEQ * 512 * 2)
#define kb  SP_(32 * MiB, 8 * MiB, (size_t)SEQ * 512 * 2)
#define vb  SP_(64 * MiB, 16 * MiB, (size_t)SEQ * 1024 * 2)
#define ob  SP_(128 * MiB, 32 * MiB, (size_t)SEQ * 1024 * 2)
#define kvT SP_(192 * MiB, 48 * MiB, (size_t)NH * NCH * 32768 * 2)
#define CT  SP_(256 * MiB, 64 * MiB, (size_t)NH * NCH * 32768 * 2)
#define bgb SP_(0, 0, (size_t)SEQ * 1024 * 2)
#define ub  SP_(64 * MiB, 16 * MiB, (size_t)SEQ * 1024 * 2)
__global__ void __launch_bounds__(NT, 2) mk_fwd(Args args) {
    extern __shared__ __attribute__((aligned(16))) unsigned char lds[];
    LAS unsigned char* L = (LAS unsigned char*)lds;
    volatile LAS unsigned* MISC = (volatile LAS unsigned*)(L + MISC_OFF);
    const int tid = threadIdx.x, lane = tid & 63, wave = __builtin_amdgcn_readfirstlane(tid >> 6), G = gridDim.x;
    const int gtid = blockIdx.x * NT + tid, gthreads = G * NT, gw = blockIdx.x * NWAVES + wave, ngw = G * NWAVES;
    unsigned char* ws = args.ws;
    gu32* ctl = (gu32*)(ws + WS_CTL);
    const float* x_in = args.in[0]; const float* norm_g = args.in[1]; const float* w_in_m = args.in[2]; const float* b_gates = args.in[3]; const float* g_hnorm = args.in[4];
    const float* w_out_m = args.in[5]; const float* w_in_c = args.in[6]; const float* w_conv = args.in[7]; const float* w_out_c = args.in[8]; const float* w_up = args.in[9]; const float* w_dn = args.in[10];
    float* ssq = (float*)(ws + WS_SSQ); float* igp = (float*)(ws + WS_IG); float* lfp = (float*)(ws + WS_LF);
    float* blast = (float*)(ws + WS_BLAST); float* mloc = (float*)(ws + WS_MLOC); float* mprev = (float*)(ws + WS_MPREV);
    float* nloc = (float*)(ws + WS_NLOC); float* nprev = (float*)(ws + WS_NPREV); bf16* NPB = (bf16*)(ws + WS_NPREV); bf16* wgT = (bf16*)(ws + WS_WGT);
    bf16* xb = (bf16*)(ws + WS_XB);
    for (int u = tid; u < (LDS_BYTES - LDSCTL_OFF) / 4; u += NT) ((LAS unsigned*)(L + LDSCTL_OFF))[u] = 0u;
    __syncthreads();
#define TIDN (wave * 64 + (int)xb_lane_now())
    const int lo = args.lo, hi = args.hi;
    XcdBarrier bar; bar.wv = (unsigned)wave; bar.bar = (unsigned*)(ctl + CW_BAR); bar.x = 0; bar.st = nullptr;
    if (!args.multi) bar = xcd_barrier_post_rank((unsigned*)(ctl + CW_BAR), MISC + 8, MISC + 12, (unsigned)wave);
#define IN(id) (lo <= (id) && (id) < hi)
    unsigned long long pr_acc = 0ull, pr_t0 = 0ull, pr_dummy = 0ull;
#define PRE(sitecls) ((PROBE_CLASS == 21 || PROBE_CLASS == (sitecls)) ? pr_acc : pr_dummy)
#define PSTART(cls) do { if (PROBE_CLASS == (cls)) pr_t0 = wall_clock64(); } while (0)
#define PEND(cls) do { if (PROBE_CLASS == (cls)) pr_acc += wall_clock64() - pr_t0; } while (0)
    int vc = (int)blockIdx.x, xmode = 0, bsel = 0;
#define SEAML(id) do { if (hi > (id) + 1) { PSTART(10); XcdBarrier bl_ = bar; asm volatile("" : "+s"(bl_.bar)); if (xmode) xcd_local_barrier(bl_, MISC + 12, MISC + 14); else xcd_barrier(bl_); PEND(10); } } while (0)
#define SEAM(id) do { if (hi > (id) + 1) { PSTART(10); XcdBarrier bl_ = bar; asm volatile("" : "+s"(bl_.bar)); if (xmode) xcd_pair_barrier(bl_, MISC + 12, MISC + 15); else xcd_barrier(bl_); PEND(10); } } while (0)

    if (IN(PH_PRO)) {
        PSTART(0);
        LAS float* scr = (LAS float*)(L + RING_OFF + wave * 16384);
        constexpr int I_IN = 16 * 96, I_OUT = 16 * 32, I_UP = 16 * 128, I_DN = 64 * 32, I_LAYER = I_IN + I_OUT + I_UP + I_DN;
        auto decode = [&](int it) -> P0Item {
            const int Ly = it / I_LAYER, j = Ly >> 1; int r = it % I_LAYER; const float* g = norm_g + (size_t)Ly * 4 * D;
            bf16* wl = (bf16*)(ws + WS_W + (size_t)Ly * W_LAYER); P0Item I;
            if (r < I_IN) { const int kb_ = r / 96, n0 = (r % 96) * 32;
                if (!(Ly & 1)) I = P0Item{w_in_m + (size_t)j * D * MIN_COLS, g, wl + W_IN / 2, MIN_COLS, n0, kb_ * 64, D, n0, (n0 >= 512 && n0 < 1024) ? 0.08838834764831845f : 1.0f};
                else { int src; if (n0 < 2048) { const int pn = n0 >> 8, within = n0 & 255; src = within < 128 ? 1024 + 128 * pn + within : 2048 + 128 * pn + (within - 128); } else src = n0 - 2048;
                    I = P0Item{w_in_c + (size_t)j * D * 3072, g, wl + W_IN / 2, 3072, src, kb_ * 64, D, n0, 1.0f}; }
                return I; } r -= I_IN;
            if (r < I_OUT) { const int kb_ = r / 32, nb = r % 32; return P0Item{((Ly & 1) ? w_out_c : w_out_m) + (size_t)j * D * D, nullptr, wl + W_OUT / 2, D, nb * 32, kb_ * 64, D, nb * 32, 1.0f}; } r -= I_OUT;
            if (r < I_UP) { const int kb_ = r / 128, nb = r % 128; return P0Item{w_up + (size_t)Ly * D * FF, g + 2 * D, wl + W_UP / 2, FF, nb * 32, kb_ * 64, D, nb * 32, 1.0f}; } r -= I_UP;
            { const int kb_ = r / 32, nb = r % 32; return P0Item{w_dn + (size_t)Ly * FF * D, nullptr, wl + W_DN / 2, D, nb * 32, kb_ * 64, FF, nb * 32, 1.0f}; }
        };
        static_assert((DEPTH * I_LAYER) % 2 == 0 && I_IN % 2 == 0, "items are taken in pairs");
        constexpr int P1_PAIRS = (DEPTH * I_LAYER - I_IN) / 2, P1_B1 = 896, P1_B2 = 4736;
        PSTART(12);
        for (int it = gw; it < I_IN / 2; it += ngw) {
            const P0Item Ia = decode(it), Ib = decode(it + I_IN / 2); float va_[32], vb_[32];
            p0_load(Ia, va_, lane); p0_load(Ib, vb_, lane);
            p0_finish(Ia, va_, scr, lane); p0_finish(Ib, vb_, scr, lane);
        }
        PEND(12);
        for (int idx = gtid; idx < 2 * 16 * D; idx += gthreads) { const int jl = idx >> 14, jg = (idx >> 10) & 15, k = idx & 1023;
            wgT[idx] = (jg < 8) ? (bf16)f2bf(w_in_m[((size_t)jl * D + k) * MIN_COLS + 3072 + jg] * norm_g[(size_t)(2 * jl) * 4 * D + k]) : (bf16)0; }
        auto xb_rows = [&](int rbeg, int rend, int w0, int nw) {
          for (int r0 = rbeg + w0 * 4; r0 < rend; r0 += nw * 4) {
            f32x4 v[4][4];
#pragma unroll
            for (int i = 0; i < 4; ++i)
#pragma unroll
                for (int j = 0; j < 4; ++j) v[i][j] = *(const GAS f32x4*)(x_in + (size_t)(r0 + i) * D + 4 * lane + 256 * j);
            float s2r[4];
#pragma unroll
            for (int i = 0; i < 4; ++i) { bf16* orow = xb + (size_t)(r0 + i) * D; float s2 = 0.f;
#pragma unroll
                for (int j = 0; j < 4; ++j) { const unsigned p0 = pk2(v[i][j][0], v[i][j][1]), p1 = pk2(v[i][j][2], v[i][j][3]);
                    const float q0 = __uint_as_float(p0 << 16), q1 = __uint_as_float(p0 & 0xffff0000u), q2 = __uint_as_float(p1 << 16), q3 = __uint_as_float(p1 & 0xffff0000u);
                    s2 += (q0 * q0 + q1 * q1) + (q2 * q2 + q3 * q3); *(GAS unsigned long long*)(orow + 4 * lane + 256 * j) = (unsigned long long)p0 | ((unsigned long long)p1 << 32); }
                s2r[i] = wave_sum(s2); }
            if (lane < 4) { const float val = lane == 0 ? s2r[0] : lane == 1 ? s2r[1] : lane == 2 ? s2r[2] : s2r[3];
                ssq[r0 + lane] = val; ssq[M + r0 + lane] = 0.f; ssq[2 * M + r0 + lane] = 0.f; ssq[3 * M + r0 + lane] = 0.f; }
          }
        };
        xb_rows(0, SEQ, gw, ngw);
        for (int idx = gtid; idx < 4 * M; idx += gthreads) ((unsigned long long*)(ws + WS_XG))[idx] = 0ull;
        PEND(0);
        SEAM(PH_PRO);
        if (!MK_MULTI) {
            if (TIDN == 0) { unsigned ok = (G == 256) ? 1u : 0u; const unsigned* bw = (const unsigned*)(ctl + CW_BAR);
#pragma unroll
                for (unsigned jx = 0; jx < 16; ++jx) { const unsigned cx = xb_ld((unsigned*)&bw[XB_XCNT(jx)]); ok &= (cx == (jx < 8u ? 32u : 0u)) ? 1u : 0u; }
                MISC[13] = ok; }
            __syncthreads();
            xmode = __builtin_amdgcn_readfirstlane((int)MISC[13]);
            if (xmode) { vc = __builtin_amdgcn_readfirstlane((int)MISC[12]) * 8 + (int)bar.x; bsel = (int)(bar.x >> 1); }
        }
        { int q0 = gw, q1 = P1_PAIRS, qs = ngw; const int pgw = ((vc & 1) * 32 + (vc >> 3)) * NWAVES + wave;
            if (xmode) { const int p = bsel; q0 = (p == 1 ? 0 : p == 2 ? P1_B1 : P1_B2) + pgw; q1 = (p == 0) ? 0 : (p == 1) ? P1_B1 : (p == 2) ? P1_B2 : P1_PAIRS; qs = 64 * NWAVES; }
            PSTART(12);
            for (int q = q0; q < q1; q += qs) {
                const P0Item Ia = decode(I_IN + q), Ib = decode(I_IN + P1_PAIRS + q); float va_[32], vb_[32];
                p0_load(Ia, va_, lane); p0_load(Ib, vb_, lane);
                p0_finish(Ia, va_, scr, lane); p0_finish(Ib, vb_, scr, lane);
            }
            PEND(12);
            if (xmode) { if (bsel != 0) { xb_rows(bsel * SEQ, (bsel + 1) * SEQ, pgw, 64 * NWAVES);
                    XcdBarrier bl_ = bar; asm volatile("" : "+s"(bl_.bar)); xcd_pair_barrier(bl_, MISC + 12, MISC + 15);
                    if (TIDN == 0) (void)xb_add((unsigned*)(ctl + CW_BAR) + XB_WDONE, 1u); } }
            else { xb_rows(SEQ, M, gw, ngw); SEAM(PH_PRO); }
        }
    }
#define WREADY() do { if (xmode) { if (wave == 0) { unsigned* bw_ = (unsigned*)(ctl + CW_BAR); XB_SPIN(xb_ld(&bw_[XB_WDONE]) < 192u, bw_); __builtin_amdgcn_fence(__ATOMIC_ACQUIRE, "agent"); asm volatile("s_waitcnt vmcnt(0)" ::: "memory"); } \
        __syncthreads(); } } while (0)

    for (int hl = 0; hl < 2 * DEPTH; ++hl) {
        const int Ly = hl >> 1, j = Ly >> 1, pid = 1 + hl * PH_PER_HL;
        const float* g = norm_g + (size_t)Ly * 4 * D;
        const bf16* wl = (const bf16*)(ws + WS_W + (size_t)Ly * W_LAYER);
        const bf16* nA; const bf16* nB; int nK; const float* ngain;
        if (!(hl & 1)) {
            if (!(Ly & 1)) {
                if (IN(pid + 0)) {
                    PSTART(1); PSTART(11);
                    #if NAIVE_GATES
                    gates_naive(xb, w_in_m + (size_t)j * D * MIN_COLS, g, b_gates + j * 8, ssq, igp, lfp, blockIdx.x * NT + TIDN, gthreads);
#else
                    gates_fast(xb, wgT + (size_t)j * 16 * D, b_gates + j * 8, ssq, igp, lfp, (vc & 7) * 256 + (vc >> 3) * 8 + wave, M / 16, TIDN & 63);
#endif
                    PEND(11);
                    pg8::Gemm gm{xb, wl + W_IN / 2, M, 3072, D}; pg8::StaticOrder S; S.init(M, 3072, G, vc);
                    pg8::EpiMlstmIn E{qb, kb, vb, ob, ssq, (LAS float*)(L + LDSCTL_OFF + 14336)};
                    pg8::gemm_phase<pg8::EpiMlstmIn, pg8::StaticOrder, true, true>(L + RING_OFF, gm, S, E, TIDN, pr_acc, PRE(23));
                    if (hl == 0) WREADY();
                    PEND(1);
                    SEAML(pid + 0);
                }
                #if NAIVE_B1
                if (IN(pid + 1)) { b1_naive(kb, vb, igp, lfp, kvT, nloc, blast, mloc, (LAS float*)(L + RING_OFF), TIDN, G); SEAM(pid + 1); }
#else
                if (IN(pid + 1)) { PSTART(2); b1_fast(kb, vb, igp, lfp, kvT, nloc, blast, mloc, L + RING_OFF, TIDN, vc); PEND(2); SEAM(pid + 1); }
#endif
                #if NAIVE_B2
                if (IN(pid + 2)) { b2_naive(kvT, CT, nloc, nprev, blast, mloc, mprev, blockIdx.x * NT + TIDN, gthreads); SEAM(pid + 2); }
#else
                if (IN(pid + 2)) { PSTART(3); b2_fast(kvT, CT, nloc, NPB, blast, mloc, mprev, L + RING_OFF, TIDN, xmode ? 64 * ((vc & 7) >> 1) + 32 * (vc & 1) + (vc >> 3) : vc, G); PEND(3); SEAM(pid + 2); }
#endif
                #if NAIVE_B3
                if (IN(pid + 3)) { b3_naive(qb, kb, vb, ob, CT, nprev, mprev, igp, lfp, g_hnorm + (size_t)j * D, (LAS float*)(L + RING_OFF), TIDN, G); SEAM(pid + 3); }
#else
                if (IN(pid + 3)) { PSTART(4); b3_fast(qb, kb, vb, ob, CT, NPB, mprev, igp, lfp, g_hnorm + (size_t)j * D, L + RING_OFF, TIDN, vc); PEND(4); SEAML(pid + 3); }
#endif
                nA = ob;
            } else {
                if (IN(pid + 0)) {
                    PSTART(5);
                    pg8::Gemm gm{xb, wl + W_IN / 2, M, 3072, D}; pg8::StaticOrder S; S.init(M, 3072, G, vc);
                    pg8::EpiConvIn E{ub, bgb, ssq, (LAS float*)(L + LDSCTL_OFF + 14336)};
                    pg8::gemm_phase<pg8::EpiConvIn, pg8::StaticOrder, true, true>(L + RING_OFF, gm, S, E, TIDN, pr_acc, PRE(23));
                    PEND(5);
                    SEAM(pid + 0);
                }
                if (IN(pid + 1)) { PSTART(6); conv_phase(bgb, ub, w_conv + (size_t)j * 3 * D, (vc & 7) * 131072, (vc >> 3) * NT + TIDN); PEND(6); SEAML(pid + 1); }
                nA = bgb;
            }
            nB = wl + W_OUT / 2; nK = D; ngain = g + D;
        } else {
            if (IN(pid + 0)) {
                PSTART(8);
                pg8::Gemm gm{xb, wl + W_UP / 2, M, FF, D}; pg8::StaticOrder S; S.init(M, FF, G, vc);
                pg8::EpiUp E{hid, ssq, (LAS float*)(L + LDSCTL_OFF + 14336)};
                pg8::gemm_phase<pg8::EpiUp, pg8::StaticOrder, true, true>(L + RING_OFF, gm, S, E, TIDN, pr_acc, PRE(24));
                PEND(8);
                SEAML(pid + 0);
            }
            nA = hid; nB = wl + W_DN / 2; nK = FF; ngain = g + 3 * D;
        }
        if (IN(pid + 4)) {
            const int last = (hl == 2 * DEPTH - 1) ? 1 : 0;
            if (hl & 1) PSTART(9); else PSTART(7);
            unsigned* xchp = (unsigned*)(ws + ((hl & 1) ? WS_XCH2 : WS_XCH));
            { pg8::Gemm gm{nA, nB, M, D, nK}; pg8::StaticOrder S; S.init(M, D, G, vc, hl & 1);
              pg8::EpiPost E{xb, args.out, ngain, ssq, (unsigned long long*)(ws + WS_XG), (unsigned)(hl + 1), xmode, (unsigned*)(ctl + CW_TMO), L + LDSCTL_OFF + 1024, last};
              pg8::gemm_phase<pg8::EpiPost, pg8::StaticOrder, true, true>(L + RING_OFF, gm, S, E, TIDN, pr_acc, PRE(22)); }
            if (hl & 1) PEND(9); else PEND(7);
            SEAML(pid + 4);
        }
    }
    if (PROBE_CLASS >= 30 && PROBE_CLASS <= 33) pr_acc += ((volatile LAS unsigned*)(L + LDSCTL_OFF + 1024 + 12288))[8 + (PROBE_CLASS - 30)];
    if (PROBE_CLASS >= 0 && blockIdx.x == 0 && TIDN == 0) { const unsigned long long t0 = wall_clock64(); while (wall_clock64() - t0 < (unsigned long long)PROBE_GAIN * pr_acc) __builtin_amdgcn_s_sleep(10); }
#undef IN
#undef SEAM
}

extern "C" void kernel_launch(void* const* d_in, const int* in_sizes, int n_in, void* d_out, int out_size, void* d_ws, size_t ws_size, hipStream_t stream) {
    static int grid = 0;
    if (grid == 0) {
        if (n_in != 11 || in_sizes[0] != M * D || out_size != M * D || ws_size < WS_END) { fprintf(stderr, "kernel_launch: unexpected shapes: n_in %d in0 %d out %d ws %zu (need %zu)\n", n_in, n_in > 0 ? in_sizes[0] : -1, out_size, ws_size, (size_t)WS_END); grid = -1; return; }
        int dev = 0, cus = 0, per_cu = 0;
        if (hipGetDevice(&dev) != hipSuccess || hipDeviceGetAttribute(&cus, hipDeviceAttributeMultiprocessorCount, dev) != hipSuccess) { grid = -1; return; }
        if (hipFuncSetAttribute((const void*)mk_fwd, hipFuncAttributeMaxDynamicSharedMemorySize, LDS_BYTES) != hipSuccess) { fprintf(stderr, "kernel_launch: hipFuncSetAttribute failed\n"); grid = -1; return; }
        if (hipOccupancyMaxActiveBlocksPerMultiprocessor(&per_cu, (const void*)mk_fwd, NT, LDS_BYTES) != hipSuccess || per_cu < 1) fprintf(stderr, "kernel_launch: occupancy query reports %d\n", per_cu);
        (void)hipGetLastError();
        grid = cus;
        if (grid != 256) { fprintf(stderr, "kernel_launch: %d CUs; the fused post-norm epilogue needs exactly 256 workgroups; nothing launched\n", grid); grid = -1; return; }
    }
    if (grid < 0) return;
    if (hipMemsetAsync((char*)d_ws + WS_CTL, 0, CTL_ZERO_BYTES, stream) != hipSuccess) return;
    Args a{};
    for (int i = 0; i < 11; ++i) a.in[i] = (const float*)d_in[i];
    a.out = (float*)d_out; a.ws = (unsigned char*)d_ws; a.pad = 0;
#if MK_MULTI
    a.multi = 1;
    int ids[64]; int n = 0; ids[n++] = PH_PRO;
    for (int hl = 0; hl < 2 * DEPTH; ++hl) { const int Ly = hl >> 1, pid = 1 + hl * PH_PER_HL;
        if (!(hl & 1)) { ids[n++] = pid; ids[n++] = pid + 1; if (!(Ly & 1)) { ids[n++] = pid + 2; ids[n++] = pid + 3; } } else ids[n++] = pid;
        ids[n++] = pid + 4; }
    for (int i = 0; i < n; ++i) { a.lo = ids[i]; a.hi = ids[i] + 1; hipLaunchKernelGGL(mk_fwd, dim3(grid), dim3(NT), LDS_BYTES, stream, a); }
#else
    a.multi = 0; a.lo = 0; a.hi = PH_END;
    hipLaunchKernelGGL(mk_fwd, dim3(grid), dim3(NT), LDS_BYTES, stream, a);
#endif
    const hipError_t le = hipPeekAtLastError();
    if (le != hipSuccess) fprintf(stderr, "kernel_launch: launch failed: %s\n", hipGetErrorName(le));
}
```

```cpp
#include <hip/hip_runtime.h>
#include <cstdio>
#include <cstdint>
#include <cmath>
#ifndef MK_MULTI
#define MK_MULTI 0
#endif
#ifndef NAIVE_GATES
#define NAIVE_GATES 0
#endif
#ifndef NAIVE_B1
#define NAIVE_B1 0
#endif
#ifndef NAIVE_B2
#define NAIVE_B2 0
#endif
#ifndef NAIVE_B3
#define NAIVE_B3 0
#endif
#ifndef PROBE_CLASS
#define PROBE_CLASS (-1)
#endif
#ifndef PROBE_GAIN
#define PROBE_GAIN 8
#endif
namespace pg8 {
#define PG8_LAS __attribute__((address_space(3)))
typedef unsigned short bf16_t;
typedef short bf16x8 __attribute__((ext_vector_type(8)));
typedef float f32x4 __attribute__((ext_vector_type(4)));
typedef unsigned u32x4 __attribute__((ext_vector_type(4)));
constexpr int BM = 256, BK = 64, HALF = 128, HTB = HALF * BK * 2  , STAGE_BYTES = 8 * HTB, NXCD = 8, WGM = 8;

__host__ __device__ __forceinline__ int lds_byte(int r, int c) { const int st = (r >> 4) * 2 + (c >> 5), rr = r & 15, cc = c & 31, ob = rr * 64 + cc * 2; return st * 1024 + (ob ^ (((ob >> 9) & 1) << 5)); }
__host__ __device__ __forceinline__ void stage_rc(int b, int& R, int& C) { const int st = b / 1024, sb = b % 1024, swz = sb ^ (((sb >> 9) & 1) << 5); R = (st >> 1) * 16 + swz / 64; C = (st & 1) * 32 + (swz % 64) / 2; }
__host__ __device__ __forceinline__ int perm32(int rho) { const int n = rho >> 4, i = rho & 15; return 8 * (i >> 2) + 4 * n + (i & 3); }

struct Unit { int pm, pn; };
struct Gemm { const bf16_t* A; const bf16_t* Bt; int M, N, K; };

struct StaticOrder {
    int nM, nN, nwg, G, c, nrev;
    __host__ __device__ void init(int M, int N, int G_, int c_, int rev = 0) { nM = M / BM; nN = N / BM; nwg = nM * nN; G = G_; c = c_; nrev = (rev && nwg % G_ == 0) ? nwg / G_ : 0; }
    __host__ __device__ bool next(int i, Unit& u) const {
        const long L = (long)((nrev > 0 && i < nrev) ? (nrev - 1 - i) : i) * G + c; if (L >= nwg || (nrev > 0 && i >= nrev)) return false;
        int wgid = (int)L; { const int q = nwg / NXCD, r = nwg % NXCD, xcd = wgid % NXCD, off = wgid / NXCD; wgid = (xcd < r ? xcd * (q + 1) : r * (q + 1) + (xcd - r) * q) + off; }
        const int nig = WGM * nN, gid = wgid / nig, fm = gid * WGM, gsz = (nM - fm) < WGM ? (nM - fm) : WGM;
        u.pm = fm + ((wgid % nig) % gsz); u.pn = (wgid % nig) / gsz; return true;
    }
    __device__ __forceinline__ void a_ready(const Unit&) const {}
    __device__ __forceinline__ void done(const Unit&) const {}
};

__device__ __forceinline__ unsigned cvt_pk_bf16(float lo, float hi) { unsigned r; asm volatile("v_cvt_pk_bf16_f32 %0, %1, %2" : "=v"(r) : "v"(lo), "v"(hi)); return r; }
constexpr float RMS_EPS = 1e-6f;
constexpr unsigned SSQ_PLANE = 32768u;
__device__ __forceinline__ float rstd_row(const float* ssq, unsigned row) { const f32x4 s = *(const f32x4*)(ssq + row * 4u); return 1.0f / sqrtf(((s[0] + s[1]) + (s[2] + s[3])) * (1.0f / 1024.0f) + RMS_EPS); }
__device__ __forceinline__ u32x4 pack8(f32x4 v0, f32x4 v1) { u32x4 w; w.x = cvt_pk_bf16(v0[0], v0[1]); w.y = cvt_pk_bf16(v0[2], v0[3]); w.z = cvt_pk_bf16(v1[0], v1[1]); w.w = cvt_pk_bf16(v1[2], v1[3]); return w; }
__device__ __forceinline__ unsigned launder0() { unsigned z = 0u; asm volatile("" : "+v"(z)); return z; }
__device__ __forceinline__ u32x4 xlane4(int xlane_src, u32x4 w) { u32x4 r; r.x = (unsigned)__builtin_amdgcn_ds_bpermute(xlane_src, (int)w.x); r.y = (unsigned)__builtin_amdgcn_ds_bpermute(xlane_src, (int)w.y);
    r.z = (unsigned)__builtin_amdgcn_ds_bpermute(xlane_src, (int)w.z); r.w = (unsigned)__builtin_amdgcn_ds_bpermute(xlane_src, (int)w.w); return r; }
__device__ __forceinline__ float sigm(float x) { return __builtin_amdgcn_rcpf(1.0f + __expf(-x)); }

#define PG8_PREF_HOOKS \
    __device__ __forceinline__ f32x4 pref_load(const Unit& u, int tid) const { f32x4 v = {0.f, 0.f, 0.f, 0.f}; if (tid < 256) { const unsigned r = (unsigned)(u.pm * BM + tid); v[0] = ssq[r]; v[1] = ssq[SSQ_PLANE + r]; v[2] = ssq[2u * SSQ_PLANE + r]; v[3] = ssq[3u * SSQ_PLANE + r]; } return v; } \
    __device__ __forceinline__ void pref_store(const f32x4 v, int buf, int tid) const { if (tid < 256) tab[buf * 256 + tid] = 1.0f / sqrtf(((v[0] + v[1]) + (v[2] + v[3])) * (1.0f / 1024.0f) + RMS_EPS); }
struct EpiMlstmIn { static constexpr bool PERM = true, AFTER_DRAIN = false, PREF = true;
    bf16_t *q, *k, *v, *o; const float* ssq; PG8_LAS float* tab;
    PG8_PREF_HOOKS
    __device__ __forceinline__ void operator()(const f32x4 (&acc)[2][2][4][2], const Unit& u, int wr, int wc, int fr, int fq, int buf) const {
        const int pn = u.pn; bf16_t* base; int ldc, colt; bool sig = false;
        if (pn < 2) { base = q; ldc = 512; colt = pn * 256; } else if (pn < 4) { base = k; ldc = 512; colt = (pn - 2) * 256; }
        else if (pn < 8) { base = v; ldc = 1024; colt = (pn - 4) * 256; } else { base = o; ldc = 1024; colt = (pn - 8) * 256; sig = true; }
        const unsigned z = launder0(), ln = fq * 16 + fr + z; const int xs = (int)(((ln & 3u) * 16u + (ln >> 2)) * 4u);
        const unsigned row0 = u.pm * BM + wr * 64 + fr + z, prow0 = u.pm * BM + wr * 64 + (ln >> 2), pcol0 = colt + wc * 32 + 8 * (ln & 3u);
#pragma unroll
        for (int ai = 0; ai < 2; ++ai)
#pragma unroll
            for (int m = 0; m < 4; ++m) { const unsigned row = row0 + ai * HALF + m * 16; const float rs = tab[buf * 256 + (int)(row - u.pm * BM)]; bf16_t* rowp = base + ((prow0 + ai * HALF + m * 16) * (unsigned)ldc + pcol0);
#pragma unroll
                for (int bj = 0; bj < 2; ++bj) { f32x4 v0 = acc[ai][bj][m][0] * rs, v1 = acc[ai][bj][m][1] * rs;
                    if (sig) {
#pragma unroll
                        for (int j = 0; j < 4; ++j) { v0[j] = sigm(v0[j]); v1[j] = sigm(v1[j]); } }
                    *(u32x4*)(rowp + bj * HALF) = xlane4(xs, pack8(v0, v1)); } }
    }
};
struct EpiConvIn { static constexpr bool PERM = true, AFTER_DRAIN = false, PREF = true;
    bf16_t *ub, *bg; const float* ssq; PG8_LAS float* tab;
    PG8_PREF_HOOKS
    __device__ __forceinline__ void operator()(const f32x4 (&acc)[2][2][4][2], const Unit& u, int wr, int wc, int fr, int fq, int buf) const {
        const int pn = u.pn; const unsigned z = launder0(), ln = fq * 16 + fr + z; const int xs = (int)(((ln & 3u) * 16u + (ln >> 2)) * 4u);
        const unsigned row0 = u.pm * BM + wr * 64 + fr + z, prow0 = u.pm * BM + wr * 64 + (ln >> 2);
        if (pn < 8) { const unsigned pcol0 = pn * 128 + wc * 32 + 8 * (ln & 3u);
#pragma unroll
            for (int ai = 0; ai < 2; ++ai)
#pragma unroll
                for (int m = 0; m < 4; ++m) { const unsigned row = row0 + ai * HALF + m * 16; const float rs = tab[buf * 256 + (int)(row - u.pm * BM)], rs2 = rs * rs;
                    const f32x4 v0 = acc[ai][0][m][0] * acc[ai][1][m][0] * rs2, v1 = acc[ai][0][m][1] * acc[ai][1][m][1] * rs2;
                    *(u32x4*)(ub + ((prow0 + ai * HALF + m * 16) * 1024u + pcol0)) = xlane4(xs, pack8(v0, v1)); }
        } else { const unsigned pcol0 = (pn - 8) * 256 + wc * 32 + 8 * (ln & 3u);
#pragma unroll
            for (int ai = 0; ai < 2; ++ai)
#pragma unroll
                for (int m = 0; m < 4; ++m) { const unsigned row = row0 + ai * HALF + m * 16; const float rs = tab[buf * 256 + (int)(row - u.pm * BM)]; bf16_t* rowp = bg + ((prow0 + ai * HALF + m * 16) * 1024u + pcol0);
#pragma unroll
                    for (int bj = 0; bj < 2; ++bj) *(u32x4*)(rowp + bj * HALF) = xlane4(xs, pack8(acc[ai][bj][m][0] * rs, acc[ai][bj][m][1] * rs)); }
        }
    }
};
struct EpiUp { static constexpr bool PERM = true, AFTER_DRAIN = false, PREF = true;
    bf16_t* hid; const float* ssq; PG8_LAS float* tab;
    PG8_PREF_HOOKS
    __device__ __forceinline__ void operator()(const f32x4 (&acc)[2][2][4][2], const Unit& u, int wr, int wc, int fr, int fq, int buf) const {
        const unsigned z = launder0(), ln = fq * 16 + fr + z; const int xs = (int)(((ln & 3u) * 16u + (ln >> 2)) * 4u);
        const unsigned row0 = u.pm * BM + wr * 64 + fr + z, prow0 = u.pm * BM + wr * 64 + (ln >> 2), pcol0 = u.pn * BM + wc * 32 + 8 * (ln & 3u);
#pragma unroll
        for (int ai = 0; ai < 2; ++ai)
#pragma unroll
            for (int m = 0; m < 4; ++m) { const unsigned row = row0 + ai * HALF + m * 16; const float rs = tab[buf * 256 + (int)(row - u.pm * BM)]; bf16_t* rowp = hid + ((prow0 + ai * HALF + m * 16) * 4096u + pcol0);
#pragma unroll
                for (int bj = 0; bj < 2; ++bj) { f32x4 v0 = acc[ai][bj][m][0] * rs, v1 = acc[ai][bj][m][1] * rs;
#pragma unroll
                    for (int j = 0; j < 4; ++j) { const float a = fmaxf(v0[j], 0.f), b = fmaxf(v1[j], 0.f); v0[j] = a * a; v1[j] = b * b; }
                    *(u32x4*)(rowp + bj * HALF) = xlane4(xs, pack8(v0, v1)); } }
    }
};
struct EpiF32P { static constexpr bool PERM = true, AFTER_DRAIN = false, PREF = false;
    float* C; int ldc;
    __device__ __forceinline__ void operator()(const f32x4 (&acc)[2][2][4][2], const Unit& u, int wr, int wc, int fr, int fq) const {
        const unsigned row0 = u.pm * BM + wr * 64 + fr + launder0(), col0 = u.pn * BM + wc * 32 + 8 * fq;
#pragma unroll
        for (int ai = 0; ai < 2; ++ai)
#pragma unroll
            for (int m = 0; m < 4; ++m) { float* rowp = C + ((row0 + ai * HALF + m * 16) * (unsigned)ldc + col0);
#pragma unroll
                for (int bj = 0; bj < 2; ++bj) { *(f32x4*)(rowp + bj * HALF) = acc[ai][bj][m][0]; *(f32x4*)(rowp + bj * HALF + 4) = acc[ai][bj][m][1]; } }
    }
};
struct EpiPost { static constexpr bool PERM = true, AFTER_DRAIN = false, PREF = false;
    bf16_t* xb; float* out; const float* gain; float* ssq; unsigned long long* xg; unsigned tag; int xm; unsigned* tmo; PG8_LAS unsigned char* lds; int last;
    __device__ __forceinline__ void operator()(const f32x4 (&acc)[2][2][4][2], const Unit& u, int wr, int wc, int fr_in, int fq_in) const {
        const int rowbase = (int)launder0(), fr = fr_in + rowbase, fq = fq_in + rowbase;
        const int wid = wr * 4 + wc, lane = fq * 16 + fr;
        PG8_LAS float* P = (PG8_LAS float*)lds;
        PG8_LAS float* S = (PG8_LAS float*)(lds + 4096);
        PG8_LAS float* P2 = (PG8_LAS float*)(lds + 8192);
        const unsigned col0 = u.pn * BM + wc * 32 + 8 * fq;
        const unsigned lnp = (unsigned)lane; const int xs = (int)(((lnp & 3u) * 16u + (lnp >> 2)) * 4u), xr = (int)((unsigned)(fr * 4 + fq) * 4u);
        const unsigned pbase = (unsigned)(rowbase + u.pm * BM + wr * 64 + (int)(lnp >> 2)) * 1024u + u.pn * BM + wc * 32 + 8 * (lnp & 3u);
        u32x4 xw[2][4][2];
#pragma unroll
        for (int ai = 0; ai < 2; ++ai)
#pragma unroll
            for (int m = 0; m < 4; ++m) { const unsigned off = pbase + (unsigned)(ai * HALF + m * 16) * 1024u;
                xw[ai][m][0] = *(const u32x4*)(xb + off); xw[ai][m][1] = *(const u32x4*)(xb + off + HALF); }
        float sp[8];
#pragma unroll
        for (int ai = 0; ai < 2; ++ai)
#pragma unroll
            for (int m = 0; m < 4; ++m) { float sv = 0.f;
#pragma unroll
                for (int bj = 0; bj < 2; ++bj)
#pragma unroll
                    for (int n = 0; n < 2; ++n) { const f32x4 x = acc[ai][bj][m][n]; sv += (x[0] * x[0] + x[1] * x[1]) + (x[2] * x[2] + x[3] * x[3]); }
                sp[ai * 4 + m] = sv; }
#pragma unroll
        for (int i = 0; i < 8; ++i) sp[i] += __shfl_xor(sp[i], 16);
#pragma unroll
        for (int i = 0; i < 8; ++i) sp[i] += __shfl_xor(sp[i], 32);
        if (fq == 0) {
#pragma unroll
            for (int i = 0; i < 8; ++i) P[((i >> 2) * HALF + wr * 64 + (i & 3) * 16 + fr) * 4 + wc] = sp[i]; }
        asm volatile("s_waitcnt lgkmcnt(0)" ::: "memory"); __builtin_amdgcn_s_barrier(); asm volatile("" ::: "memory");
        const int row = wid * 32 + (lane & 31); const unsigned grow = (unsigned)(rowbase + u.pm * BM + row);
        if (lane < 32) { const f32x4 a = *(const PG8_LAS f32x4*)(P + row * 4); const float t = (a[0] + a[1]) + (a[2] + a[3]);
            const unsigned long long g = ((unsigned long long)tag << 32) | (unsigned long long)__float_as_uint(t); unsigned long long* gp = xg + (size_t)u.pn * SSQ_PLANE + grow;
            if (xm) __hip_atomic_store(gp, g, __ATOMIC_RELAXED, __HIP_MEMORY_SCOPE_WORKGROUP); else __hip_atomic_store(gp, g, __ATOMIC_RELAXED, __HIP_MEMORY_SCOPE_AGENT); }
        { const unsigned long long* gq = xg + (size_t)(2 * (lane >> 5)) * SSQ_PLANE + grow; float tsum; bool ok; unsigned spins = 0u;
            for (;;) {
                const unsigned long long ga = __hip_atomic_load(gq, __ATOMIC_RELAXED, __HIP_MEMORY_SCOPE_AGENT), gb = __hip_atomic_load(gq + SSQ_PLANE, __ATOMIC_RELAXED, __HIP_MEMORY_SCOPE_AGENT);
                ok = ((unsigned)(ga >> 32) == tag) && ((unsigned)(gb >> 32) == tag); tsum = __uint_as_float((unsigned)ga) + __uint_as_float((unsigned)gb);
                if (__builtin_amdgcn_ballot_w64(ok) == ~0ull) break;
                if (++spins > (1u << 20)) { if (lane == 0) __hip_atomic_store(tmo, 1u, __ATOMIC_RELAXED, __HIP_MEMORY_SCOPE_AGENT); break; }
                __builtin_amdgcn_s_sleep(1); }
            tsum += __shfl_xor(tsum, 32); const bool ok2 = ok && (bool)__shfl_xor((int)ok, 32);
            if (lane < 32) S[row] = ok2 ? 1.0f / sqrtf(tsum * (1.0f / 1024.0f) + RMS_EPS) : __builtin_nanf(""); }
        asm volatile("s_waitcnt lgkmcnt(0)" ::: "memory"); __builtin_amdgcn_s_barrier(); asm volatile("" ::: "memory");
        f32x4 gv[2][2];
#pragma unroll
        for (int bj = 0; bj < 2; ++bj) { gv[bj][0] = *(const f32x4*)(gain + col0 + bj * HALF); gv[bj][1] = *(const f32x4*)(gain + col0 + bj * HALF + 4); }
        float s2v[8];
#pragma unroll
        for (int ai = 0; ai < 2; ++ai)
#pragma unroll
            for (int m = 0; m < 4; ++m) { const int rl = ai * HALF + wr * 64 + m * 16 + fr; const float c = S[rl]; const unsigned off = (unsigned)(rowbase + u.pm * BM + rl) * 1024u + col0; float s2 = 0.f;
#pragma unroll
                for (int bj = 0; bj < 2; ++bj) { const u32x4 xv = xlane4(xr, xw[ai][m][bj]);
                    f32x4 x0, x1; x0[0] = __uint_as_float(xv.x << 16); x0[1] = __uint_as_float(xv.x & 0xffff0000u); x0[2] = __uint_as_float(xv.y << 16); x0[3] = __uint_as_float(xv.y & 0xffff0000u);
                    x1[0] = __uint_as_float(xv.z << 16); x1[1] = __uint_as_float(xv.z & 0xffff0000u); x1[2] = __uint_as_float(xv.w << 16); x1[3] = __uint_as_float(xv.w & 0xffff0000u);
                    x0 = x0 + acc[ai][bj][m][0] * gv[bj][0] * c; x1 = x1 + acc[ai][bj][m][1] * gv[bj][1] * c;
                    if (last) { *(f32x4*)(out + off + bj * HALF) = x0; *(f32x4*)(out + off + bj * HALF + 4) = x1; }
                    else { const u32x4 w = pack8(x0, x1); *(u32x4*)(xb + pbase + (unsigned)(ai * HALF + m * 16) * 1024u + bj * HALF) = xlane4(xs, w);
                        const float r0 = __uint_as_float(w.x << 16), r1 = __uint_as_float(w.x & 0xffff0000u), r2 = __uint_as_float(w.y << 16), r3 = __uint_as_float(w.y & 0xffff0000u);
                        const float r4 = __uint_as_float(w.z << 16), r5 = __uint_as_float(w.z & 0xffff0000u), r6 = __uint_as_float(w.w << 16), r7 = __uint_as_float(w.w & 0xffff0000u);
                        s2 += ((r0 * r0 + r1 * r1) + (r2 * r2 + r3 * r3)) + ((r4 * r4 + r5 * r5) + (r6 * r6 + r7 * r7)); } }
                s2v[ai * 4 + m] = s2; }
#pragma unroll
        for (int i = 0; i < 8; ++i) s2v[i] += __shfl_xor(s2v[i], 16);
#pragma unroll
        for (int i = 0; i < 8; ++i) s2v[i] += __shfl_xor(s2v[i], 32);
        if (fq == 0) {
#pragma unroll
            for (int i = 0; i < 8; ++i) P2[((i >> 2) * HALF + wr * 64 + (i & 3) * 16 + fr) * 4 + wc] = s2v[i]; }
        asm volatile("s_waitcnt lgkmcnt(0)" ::: "memory"); __builtin_amdgcn_s_barrier(); asm volatile("" ::: "memory");
        if (lane < 32) { const f32x4 a = *(const PG8_LAS f32x4*)(P2 + row * 4); ssq[(unsigned)u.pn * SSQ_PLANE + grow] = (a[0] + a[1]) + (a[2] + a[3]); }
    }
};
template <class Epi, class Sched, bool ALIGN_EPI = false, bool SP2 = false>
__device__ __forceinline__ void gemm_phase(PG8_LAS unsigned char* lds, const Gemm g, const Sched& S, const Epi& E, const int tid_in, unsigned long long& pr_k, unsigned long long& pr_e) {
    const int tid = tid_in, wid = __builtin_amdgcn_readfirstlane(tid >> 6), lane = tid & 63, wr = wid >> 2, wc = wid & 3, fr = lane & 15, fq = lane >> 4;
    const int K = g.K, nt = K / BK;
    unsigned voffA[2], voffB[2];
#pragma unroll
    for (int i = 0; i < 2; ++i) { int R, C; stage_rc(tid * 16 + i * 8192, R, C); const int Rb = Epi::PERM ? ((R & ~31) + perm32(R & 31)) : R;
        voffA[i] = (unsigned)(R * K + C) * 2u; voffB[i] = (unsigned)(Rb * K + C) * 2u; }
    const size_t kstep = (size_t)(BK * 2);
    const size_t hstep = (size_t)HALF * K * 2;
    const size_t tstep = 2 * hstep;
    const unsigned ldsw = (unsigned)wid * 1024u;
    const int aoff = lds_byte(wr * 64 + fr, fq * 8), boff = lds_byte(wc * 32 + fr, fq * 8);
#define PG8_SA(b, h) (((b) * 2 + (h)) * HTB)
#define PG8_SB(b, h) ((4 + (b) * 2 + (h)) * HTB)
#define PG8_STAGE(bufoff, gbase, voff) do { _Pragma("unroll") for (int _i = 0; _i < 2; ++_i) \
        __builtin_amdgcn_global_load_lds((const unsigned*)((const char*)(gbase) + (voff)[_i]), (PG8_LAS unsigned*)(lds + (bufoff) + ldsw + _i * 8192), 16, 0, 0); } while (0)
#define PG8_LDA(dst, b, h) do { _Pragma("unroll") for (int m = 0; m < 4; ++m) _Pragma("unroll") for (int k = 0; k < 2; ++k) dst[m][k] = *(const PG8_LAS bf16x8*)(lds + PG8_SA(b, h) + aoff + m * 2048 + k * 1024); } while (0)
#define PG8_LDB(dst, b, h) do { _Pragma("unroll") for (int n = 0; n < 2; ++n) _Pragma("unroll") for (int k = 0; k < 2; ++k) dst[n][k] = *(const PG8_LAS bf16x8*)(lds + PG8_SB(b, h) + boff + n * 2048 + k * 1024); } while (0)
#define PG8_MMA(ai, bj, At, Bt) do { __builtin_amdgcn_s_setprio(1); _Pragma("unroll") for (int m = 0; m < 4; ++m) _Pragma("unroll") for (int n = 0; n < 2; ++n) _Pragma("unroll") for (int k = 0; k < 2; ++k) \
        acc[ai][bj][m][n] = __builtin_amdgcn_mfma_f32_16x16x32_bf16(Bt[n][k], At[m][k], acc[ai][bj][m][n], 0, 0, 0); __builtin_amdgcn_s_setprio(0); } while (0)
#define PG8_WAIT_V(n) asm volatile("s_waitcnt vmcnt(" #n ")" ::: "memory")
#define PG8_WAIT_L(n) asm volatile("s_waitcnt lgkmcnt(" #n ")" ::: "memory")
#define PG8_BAR __builtin_amdgcn_s_barrier()
#define PG8_SCHED __builtin_amdgcn_sched_barrier(0)
    Unit cur, nxt; int ui = 0;
    if (!S.next(0, cur)) return;
    f32x4 acc[2][2][4][2];
#pragma unroll
    for (int a = 0; a < 2; ++a)
#pragma unroll
        for (int b = 0; b < 2; ++b)
#pragma unroll
            for (int m = 0; m < 4; ++m)
#pragma unroll
                for (int n = 0; n < 2; ++n) acc[a][b][m][n] = (f32x4){0.f, 0.f, 0.f, 0.f};
    bf16x8 At[4][2], B0[2][2], B1[2][2];
    const char* cA = (const char*)g.A + (size_t)cur.pm * tstep; const char* cB = (const char*)g.Bt + (size_t)cur.pn * tstep;
    S.a_ready(cur);
    if constexpr (Epi::PREF) { const f32x4 pv0 = E.pref_load(cur, tid); E.pref_store(pv0, 0, tid); }
    if constexpr (SP2) {
        PG8_STAGE(PG8_SB(0, 0), cB, voffB); PG8_STAGE(PG8_SB(0, 1), cB + hstep, voffB); PG8_STAGE(PG8_SA(0, 0), cA, voffA); PG8_STAGE(PG8_SA(0, 1), cA + hstep, voffA);
        if (wr == 1) PG8_BAR;
        PG8_WAIT_V(2); PG8_BAR;
        PG8_STAGE(PG8_SB(1, 0), cB + kstep, voffB); PG8_STAGE(PG8_SA(1, 0), cA + kstep, voffA); PG8_STAGE(PG8_SB(1, 1), cB + hstep + kstep, voffB);
        PG8_WAIT_V(6); PG8_BAR;
    } else {
        PG8_STAGE(PG8_SB(0, 0), cB, voffB); PG8_STAGE(PG8_SA(0, 0), cA, voffA); PG8_STAGE(PG8_SB(0, 1), cB + hstep, voffB); PG8_STAGE(PG8_SA(0, 1), cA + hstep, voffA);
        if (wr == 1) PG8_BAR;
        PG8_WAIT_V(4); PG8_BAR;
        PG8_STAGE(PG8_SB(1, 0), cB + kstep, voffB); PG8_STAGE(PG8_SA(1, 0), cA + kstep, voffA); PG8_STAGE(PG8_SB(1, 1), cB + hstep + kstep, voffB);
        PG8_WAIT_V(6); PG8_BAR;
    }
    for (;;) {
        const bool has_next = S.next(ui + 1, nxt);
        const char* nA = has_next ? (const char*)g.A + (size_t)nxt.pm * tstep : cA + (size_t)(nt - 2) * kstep; const char* nB = has_next ? (const char*)g.Bt + (size_t)nxt.pn * tstep : cB + (size_t)(nt - 2) * kstep;
        unsigned long long pt0 = 0ull; if (PROBE_CLASS == 20) pt0 = wall_clock64(); if (PROBE_CLASS == 50) pt0 = (unsigned long long)clock64();
        for (int t = 0; t < nt; t += 2) {
            const bool last = (t == nt - 2);
            const char* a1 = cA + (size_t)(t + 1) * kstep;
            const char* a2 = last ? nA : cA + (size_t)(t + 2) * kstep; const char* b2 = last ? nB : cB + (size_t)(t + 2) * kstep;
            const char* a3 = a2 + kstep; const char* b3 = b2 + kstep;
            if (last && has_next) S.a_ready(nxt);
            if constexpr (SP2) {
            PG8_LDB(B0, 0, 0); PG8_LDB(B1, 0, 1); PG8_SCHED; PG8_LDA(At, 0, 0); PG8_STAGE(PG8_SA(1, 1), a1 + hstep, voffA);
            PG8_WAIT_V(8); PG8_WAIT_L(0); PG8_BAR; PG8_MMA(0, 0, At, B0); PG8_MMA(0, 1, At, B1); PG8_BAR; PG8_SCHED;
            PG8_LDA(At, 0, 1); PG8_STAGE(PG8_SB(0, 0), b2, voffB); PG8_STAGE(PG8_SB(0, 1), b2 + hstep, voffB); PG8_STAGE(PG8_SA(0, 0), a2, voffA);
            PG8_WAIT_V(8); PG8_WAIT_L(0); PG8_BAR; PG8_MMA(1, 0, At, B0); PG8_MMA(1, 1, At, B1); PG8_BAR; PG8_SCHED;
            PG8_LDB(B0, 1, 0); PG8_LDB(B1, 1, 1); PG8_SCHED; PG8_LDA(At, 1, 0); PG8_STAGE(PG8_SA(0, 1), a2 + hstep, voffA);
            PG8_WAIT_V(8); PG8_WAIT_L(0); PG8_BAR; PG8_MMA(0, 0, At, B0); PG8_MMA(0, 1, At, B1); PG8_BAR; PG8_SCHED;
            PG8_LDA(At, 1, 1); PG8_STAGE(PG8_SB(1, 0), b3, voffB); PG8_STAGE(PG8_SB(1, 1), b3 + hstep, voffB); PG8_STAGE(PG8_SA(1, 0), a3, voffA);
            PG8_WAIT_V(8); PG8_WAIT_L(0); PG8_BAR; PG8_MMA(1, 0, At, B0); PG8_MMA(1, 1, At, B1); PG8_BAR; PG8_SCHED;
            } else {
            PG8_LDB(B0, 0, 0); PG8_SCHED; PG8_LDA(At, 0, 0); PG8_STAGE(PG8_SA(1, 1), a1 + hstep, voffA);
            PG8_WAIT_L(8); PG8_BAR; PG8_WAIT_L(0); PG8_MMA(0, 0, At, B0); PG8_BAR; PG8_SCHED;
            PG8_LDB(B1, 0, 1); PG8_STAGE(PG8_SB(0, 0), b2, voffB);
            PG8_BAR; PG8_WAIT_L(0); PG8_MMA(0, 1, At, B1); PG8_BAR;
            PG8_LDA(At, 0, 1); PG8_STAGE(PG8_SA(0, 0), a2, voffA);
            PG8_BAR; PG8_WAIT_L(0); PG8_MMA(1, 0, At, B0); PG8_BAR; PG8_SCHED;
            PG8_STAGE(PG8_SB(0, 1), b2 + hstep, voffB);
            PG8_WAIT_V(6); PG8_BAR; PG8_MMA(1, 1, At, B1); PG8_BAR;
            PG8_LDB(B0, 1, 0); PG8_SCHED; PG8_LDA(At, 1, 0); PG8_STAGE(PG8_SA(0, 1), a2 + hstep, voffA);
            PG8_WAIT_L(8); PG8_BAR; PG8_WAIT_L(0); PG8_MMA(0, 0, At, B0); PG8_BAR; PG8_SCHED;
            PG8_LDB(B1, 1, 1); PG8_STAGE(PG8_SB(1, 0), b3, voffB);
            PG8_BAR; PG8_WAIT_L(0); PG8_MMA(0, 1, At, B1); PG8_BAR;
            PG8_LDA(At, 1, 1); PG8_STAGE(PG8_SA(1, 0), a3, voffA);
            PG8_BAR; PG8_WAIT_L(0); PG8_MMA(1, 0, At, B0); PG8_BAR; PG8_SCHED;
            PG8_STAGE(PG8_SB(1, 1), b3 + hstep, voffB);
            PG8_WAIT_V(6); PG8_BAR; PG8_MMA(1, 1, At, B1); PG8_BAR;
            }
        }
        if (PROBE_CLASS == 20) pr_k += wall_clock64() - pt0;
        if (PROBE_CLASS == 50) pr_k += ((unsigned long long)clock64() - pt0) >> 8;
        if (PROBE_CLASS >= 21) pt0 = wall_clock64();
        if constexpr (ALIGN_EPI) { if (wr == 0) PG8_BAR; }
        if constexpr (!Epi::AFTER_DRAIN) {
            if constexpr (Epi::PREF) { f32x4 pvn = {0.f, 0.f, 0.f, 0.f}; if (has_next) pvn = E.pref_load(nxt, tid); E(acc, cur, wr, wc, fr, fq, ui & 1); if (has_next) E.pref_store(pvn, (ui + 1) & 1, tid); }
            else E(acc, cur, wr, wc, fr, fq);
            S.done(cur); }
        if (PROBE_CLASS >= 21) pr_e += wall_clock64() - pt0;
        if (!has_next) break;
#pragma unroll
        for (int a = 0; a < 2; ++a)
#pragma unroll
            for (int b = 0; b < 2; ++b)
#pragma unroll
                for (int m = 0; m < 4; ++m)
#pragma unroll
                    for (int n = 0; n < 2; ++n) acc[a][b][m][n] = (f32x4){0.f, 0.f, 0.f, 0.f};
        cur = nxt; cA = nA; cB = nB; ++ui;
        if constexpr (ALIGN_EPI) { if (wr == 1) PG8_BAR; }
    }
    unsigned long long pt1 = 0ull; if (PROBE_CLASS >= 21) pt1 = wall_clock64();
    PG8_WAIT_V(0);
    if constexpr (!ALIGN_EPI) { if (wr == 0) PG8_BAR; }
    PG8_BAR;
    if constexpr (Epi::AFTER_DRAIN) { E.fused(acc, cur, wr, wc, fr, fq, lds, wid, lane); S.done(cur); }
    if (PROBE_CLASS >= 21) pr_e += wall_clock64() - pt1;
#undef PG8_SA
#undef PG8_SB
#undef PG8_STAGE
#undef PG8_LDA
#undef PG8_LDB
#undef PG8_MMA
#undef PG8_WAIT_V
#undef PG8_WAIT_L
#undef PG8_BAR
#undef PG8_SCHED
}
}
#define GAS __attribute__((address_space(1)))
#define LAS __attribute__((address_space(3)))
typedef unsigned short bf16;
typedef unsigned v4u __attribute__((ext_vector_type(4)));
typedef float f32x4 __attribute__((ext_vector_type(4)));
typedef short bf16x8 __attribute__((ext_vector_type(8)));
typedef GAS unsigned gu32;
typedef GAS unsigned long long gu64;
#define RLX_AGENT __ATOMIC_RELAXED, __HIP_MEMORY_SCOPE_AGENT
#define LDS_WAIT() asm volatile("s_waitcnt lgkmcnt(0)" ::: "memory")
#define VM_WAIT() asm volatile("s_waitcnt vmcnt(0)" ::: "memory")
__device__ __forceinline__ unsigned long long rt() { return __builtin_amdgcn_s_memrealtime(); }
__device__ __forceinline__ unsigned f2bf(float f) { unsigned u = __builtin_bit_cast(unsigned, f); return (u + 0x7fffu + ((u >> 16) & 1u)) >> 16; }
__device__ __forceinline__ unsigned pk2(float lo, float hi) { return f2bf(lo) | (f2bf(hi) << 16); }

#define XB_TMO      128
#define XB_XCNT(j)  (256  + 64 * (j))
#define XB_XSUB(j)  (1280 + 64 * (j))
#define XB_XGEN(j)  (2304 + 64 * (j))
#define XB_TOP      3328
#define XB_TOPGEN   3392
#define XCD_BAR_WORDS 3456
#define XB_SPIN_CAP (1u << 18)

__device__ __forceinline__ unsigned xb_ld(unsigned* p)              { return __hip_atomic_load(p, __ATOMIC_RELAXED, __HIP_MEMORY_SCOPE_AGENT); }
__device__ __forceinline__ unsigned xb_add(unsigned* p, unsigned v) { return __hip_atomic_fetch_add(p, v, __ATOMIC_RELAXED, __HIP_MEMORY_SCOPE_AGENT); }
__device__ __forceinline__ unsigned xb_xcc_id() { return (unsigned)__builtin_amdgcn_s_getreg((3 << 11) | 20) & 0xFu; }
#define XB_SPIN(cond, bar) do { unsigned _sp = 0; while (cond) { __builtin_amdgcn_s_sleep(1); \
    if ((++_sp & 255u) == 0u) { if (xb_ld(&(bar)[XB_TMO])) break; if (_sp > XB_SPIN_CAP) { atomicAdd(&(bar)[XB_TMO], 1u); break; } } } } while (0)

__device__ __forceinline__ unsigned xb_lane_now() { unsigned z; asm volatile("v_mov_b32 %0, 0" : "=v"(z)); return __builtin_amdgcn_mbcnt_hi(~0u, __builtin_amdgcn_mbcnt_lo(~0u, z)); }
#define XB_T0(b) ((b).wv == 0u && xb_lane_now() == 0u)
struct XcdBarrier {
    unsigned wv;
    unsigned* bar; unsigned x;
    volatile LAS unsigned* st;
};

__device__ __forceinline__ XcdBarrier xcd_barrier_post(unsigned* bar, volatile LAS unsigned* st) {
    XcdBarrier b; b.bar = bar; b.x = xb_xcc_id(); b.st = st;
    if (threadIdx.x == 0) (void)xb_add(&bar[XB_XCNT(b.x)], 1u);
    return b;
}
__device__ __forceinline__ void xcd_barrier_complete(unsigned* bar, unsigned x, unsigned& nloc, unsigned& nx) {
    const unsigned G = gridDim.x * gridDim.y * gridDim.z;
    unsigned sum, cnt, mine, sp = 0u;
    for (;;) {
        sum = 0u; cnt = 0u; mine = 0u;
#pragma unroll
        for (unsigned j = 0; j < 16; ++j) { const unsigned c = xb_ld(&bar[XB_XCNT(j)]); sum += c; cnt += (c > 0u) ? 1u : 0u; mine = (j == x) ? c : mine; }
        if (sum == G) break;
        __builtin_amdgcn_s_sleep(1);
        if ((++sp & 255u) == 0u) { if (xb_ld(&bar[XB_TMO])) break; if (sp > XB_SPIN_CAP) { atomicAdd(&bar[XB_TMO], 1u); break; } }
    }
    nloc = mine > 0u ? mine : 1u; nx = cnt > 0u ? cnt : 1u;
}

__device__ __forceinline__ void xcd_barrier(const XcdBarrier& b) {
    asm volatile("s_waitcnt vmcnt(0)" ::: "memory");
    __syncthreads();
    if (XB_T0(b)) {
        unsigned* bar = b.bar;
        __builtin_amdgcn_s_waitcnt(0);
        unsigned nloc = b.st[0], nx = b.st[1];
        if (nloc == 0u) { xcd_barrier_complete(bar, b.x, nloc, nx); b.st[0] = nloc; b.st[1] = nx; }
        const unsigned old = xb_add(&bar[XB_XSUB(b.x)], 1u);
        const unsigned gen = old / nloc;
        if (old + 1u == (gen + 1u) * nloc) {
            __builtin_amdgcn_fence(__ATOMIC_RELEASE, "agent");
            asm volatile("s_waitcnt vmcnt(0)" ::: "memory");
            const unsigned og = xb_add(&bar[XB_TOP], 1u);
            const unsigned tg = og / nx;
            if (og + 1u == (tg + 1u) * nx) xb_add(&bar[XB_TOPGEN], 1u);
            else XB_SPIN(xb_ld(&bar[XB_TOPGEN]) == tg, bar);
            __builtin_amdgcn_fence(__ATOMIC_ACQUIRE, "agent");
            xb_add(&bar[XB_XGEN(b.x)], 1u);
            asm volatile("s_waitcnt vmcnt(0)" ::: "memory");
        } else {
            XB_SPIN(xb_ld(&bar[XB_XGEN(b.x)]) == gen, bar);
            __builtin_amdgcn_fence(__ATOMIC_ACQUIRE, "agent");
            asm volatile("s_waitcnt vmcnt(0)" ::: "memory");
        }
    }
    __syncthreads();
}
constexpr int NWAVES = 8, NT = 512;
constexpr int BATCH = 4, SEQ = 8192, D = 1024, FF = 4096, M = BATCH * SEQ, DEPTH = 4;
constexpr int NH = 4, DK = 128, DV = 256, CH = 128, NCH = SEQ / CH, NUNIT = BATCH * NH * NCH;
constexpr int MIN_COLS = 3080;
constexpr float EPS = 1e-6f, GATE_CAP = 15.0f;
constexpr size_t MiB = 1u << 20;
constexpr size_t WS_CTL = 0, CTL_ZERO_BYTES = 1 * MiB;
constexpr size_t WS_SSQ = 1 * MiB;
constexpr size_t WS_XCH = 1 * MiB + 512 * 1024;
constexpr size_t WS_IG = 2 * MiB, WS_LF = 2 * MiB + 512 * 1024;
constexpr size_t WS_BLAST = 3 * MiB, WS_MLOC = 3 * MiB + 128 * 1024, WS_MPREV = 3 * MiB + 256 * 1024;
constexpr size_t WS_NLOC = 3 * MiB + 512 * 1024, WS_NPREV = 4 * MiB;
constexpr size_t WS_WGT = 4 * MiB + 512 * 1024;
constexpr size_t WS_XCH2 = 5 * MiB;
constexpr size_t WS_XG = 6 * MiB;
constexpr size_t WS_W = 8 * MiB, W_LAYER = 24 * MiB, W_IN = 0, W_OUT = 6 * MiB, W_UP = 8 * MiB, W_DN = 16 * MiB;
constexpr size_t WS_XB = 104 * MiB;
constexpr size_t WS_S = 168 * MiB;
constexpr size_t WS_HID = WS_S;
constexpr size_t WS_Q = WS_S, WS_K = WS_S + 32 * MiB, WS_V = WS_S + 64 * MiB, WS_O = WS_S + 128 * MiB;
constexpr size_t WS_KVT = WS_S + 192 * MiB, WS_CT = WS_S + 256 * MiB;
constexpr size_t WS_BG = WS_S, WS_U = WS_S + 64 * MiB;
constexpr size_t WS_END = WS_S + 320 * MiB;
constexpr int CW_TMO = 0, CW_CODE = 1, CW_BAR = 4096, CW_SEAM = 16384;
constexpr int RING_OFF = 0, RING_BYTES = 131072, LDSCTL_OFF = RING_BYTES, MISC_OFF = LDSCTL_OFF + 320, LDS_BYTES = 147456;
constexpr int PH_PRO = 0, PH_PER_HL = 6, PH_END = 1 + 7 * PH_PER_HL + 5;

__device__ __forceinline__ int launder_i(int v) { asm volatile("" : "+v"(v)); return v; }
__device__ __forceinline__ float bf2f(bf16 b) { return __uint_as_float(((unsigned)b) << 16); }
__device__ __forceinline__ float wave_sum(float v) {
#pragma unroll
    for (int o = 1; o < 64; o <<= 1) v += __shfl_xor(v, o);
    return v;
}
struct P0Item { const float* W; const float* gain; bf16* WT; int ldw, src_col0, k0, K, dst_row0; float cscale; };
__device__ __forceinline__ void p0_load(const P0Item& I, float (&v)[32], int lane) {
#pragma unroll
    for (int i = 0; i < 32; ++i) { const int kk = 2 * i + (lane >> 5); v[i] = I.W[(size_t)(I.k0 + kk) * I.ldw + I.src_col0 + (lane & 31)]; }
}
__device__ __forceinline__ void p0_finish(const P0Item& I, const float (&v)[32], LAS float* scr, int lane) {
#pragma unroll
    for (int i = 0; i < 32; ++i) scr[(2 * i + (lane >> 5)) * 33 + (lane & 31)] = v[i];
    LDS_WAIT(); asm volatile("" ::: "memory");
    const int c = lane & 7;
    f32x4 g0 = {I.cscale, I.cscale, I.cscale, I.cscale}, g1 = g0;
    if (I.gain) { g0 = *(const GAS f32x4*)(I.gain + I.k0 + 8 * c) * I.cscale; g1 = *(const GAS f32x4*)(I.gain + I.k0 + 8 * c + 4) * I.cscale; }
#pragma unroll
    for (int j = 0; j < 4; ++j) { const int n = (lane >> 3) + 8 * j; const LAS float* s = scr + (8 * c) * 33 + n;
        v4u o; o.x = pk2(s[0 * 33] * g0[0], s[1 * 33] * g0[1]); o.y = pk2(s[2 * 33] * g0[2], s[3 * 33] * g0[3]); o.z = pk2(s[4 * 33] * g1[0], s[5 * 33] * g1[1]); o.w = pk2(s[6 * 33] * g1[2], s[7 * 33] * g1[3]);
        *(GAS v4u*)(I.WT + (size_t)(I.dst_row0 + n) * I.K + I.k0 + 8 * c) = o; }
    LDS_WAIT(); asm volatile("" ::: "memory");
}
struct Args { const float* in[11]; float* out; unsigned char* ws; int lo, hi, multi, pad; };

__device__ __forceinline__ void gates_naive(const bf16* xb, const float* Win, const float* g0, const float* bias, const float* ssq, float* ig, float* lf, int gtid, int gthreads) {
    for (int item = gtid; item < M * 8; item += gthreads) { const int row = item >> 3, j = item & 7; float s = 0.f;
        for (int k = 0; k < D; ++k) s += bf2f(xb[(size_t)row * D + k]) * g0[k] * Win[(size_t)k * MIN_COLS + 3072 + j];
        const float4 q = *(const float4*)(ssq + (size_t)row * 4); const float rs = 1.0f / sqrtf((q.x + q.y + q.z + q.w) * (1.0f / D) + EPS);
        float v = s * rs + bias[j]; v = GATE_CAP * tanhf(v / GATE_CAP);
        if (j < 4) ig[(size_t)row * 4 + j] = v; else lf[(size_t)row * 4 + (j - 4)] = fminf(v, 0.f) - log1pf(expf(-fabsf(v))); }
}
__device__ __forceinline__ void b1_naive(const bf16* kb, const bf16* vb, const float* ig, const float* lf, bf16* kvT, float* nloc, float* blast, float* mloc, LAS float* sm, int tid, int G) {
    LAS float* s_ig = sm; LAS float* s_lf = sm + 128; LAS float* s_b = sm + 256; LAS float* s_w = sm + 384;
    for (int u = blockIdx.x; u < NUNIT; u += G) {
        const int b = u >> 8, h = (u >> 6) & 3, c = u & 63; const size_t row0 = (size_t)b * SEQ + c * CH;
        if (tid < 128) { s_ig[tid] = ig[(row0 + tid) * 4 + h]; s_lf[tid] = lf[(row0 + tid) * 4 + h]; }
        __syncthreads();
        if (tid == 0) { float a = 0.f; for (int l = 0; l < 128; ++l) { a += s_lf[l]; s_b[l] = a; } const float bl = a; float mx = -INFINITY;
            for (int l = 0; l < 128; ++l) mx = fmaxf(mx, bl - s_b[l] + s_ig[l]);
            for (int l = 0; l < 128; ++l) s_w[l] = expf(bl - s_b[l] + s_ig[l] - mx);
            blast[u] = bl; mloc[u] = mx; }
        __syncthreads();
        const int d = tid & 127, eq = tid >> 7;
        for (int j = 0; j < 64; ++j) { const int e = eq + 4 * j; float s = 0.f;
            for (int l = 0; l < 128; ++l) s += s_w[l] * bf2f(kb[(row0 + l) * 512 + h * 128 + d]) * bf2f(vb[(row0 + l) * 1024 + h * 256 + e]);
            kvT[((size_t)u * 256 + e) * 128 + d] = (bf16)f2bf(s); }
        if (tid < 128) { float s = 0.f; for (int l = 0; l < 128; ++l) s += s_w[l] * bf2f(kb[(row0 + l) * 512 + h * 128 + tid]); nloc[(size_t)u * 128 + tid] = s; }
        __syncthreads();
    }
}
__device__ __forceinline__ void b2_naive(const bf16* kvT, bf16* CT, const float* nloc, float* nprev, const float* blast, const float* mloc, float* mprev, int gtid, int gthreads) {
    for (int idx = gtid; idx < 16 * 32768; idx += gthreads) { const int bh = idx >> 15, ed = idx & 32767; float m = 0.f, C = 0.f;
        for (int c = 0; c < NCH; ++c) { const int u = bh * 64 + c; const size_t off = (size_t)u * 32768 + ed; CT[off] = (bf16)f2bf(C);
            const float bl = blast[u], ml = mloc[u], mn = fmaxf(bl + m, ml), a = expf(bl + m - mn), s = expf(ml - mn); C = a * C + s * bf2f(kvT[off]); m = mn; } }
    for (int idx = gtid; idx < 16 * 128; idx += gthreads) { const int bh = idx >> 7, d = idx & 127; float m = 0.f, n = 0.f;
        for (int c = 0; c < NCH; ++c) { const int u = bh * 64 + c; nprev[(size_t)u * 128 + d] = n;
            const float bl = blast[u], ml = mloc[u], mn = fmaxf(bl + m, ml), a = expf(bl + m - mn), s = expf(ml - mn); n = a * n + s * nloc[(size_t)u * 128 + d]; m = mn; } }
    for (int idx = gtid; idx < 16; idx += gthreads) { float m = 0.f;
        for (int c = 0; c < NCH; ++c) { const int u = idx * 64 + c; mprev[u] = m; m = fmaxf(blast[u] + m, mloc[u]); } }
}
__device__ __forceinline__ void b3_naive(const bf16* qb, const bf16* kb, const bf16* vb, bf16* ob, const bf16* CT, const float* nprev, const float* mprev, const float* ig, const float* lf, const float* ghn,
                                         LAS float* sm, int tid, int G) {
    const int sb = tid >> 7, st = tid & 127;
    LAS float* s_a = sm + sb * 512; LAS float* s_P = s_a + 128; LAS float* s_red = s_a + 256; LAS float* s_misc = s_a + 384;
    const int niter = (M * NH) / (G * 4);
    for (int it = 0; it < niter; ++it) {
        const int item = (it * G + blockIdx.x) * 4 + sb; const int row = item >> 2, h = item & 3;
        const int b = row >> 13, tpos = row & 8191, c = tpos >> 7, tl = tpos & 127, unit = (b * 4 + h) * 64 + c; const size_t row0 = (size_t)row - tl;
        { float bs = 0.f; for (int l = 0; l <= st; ++l) bs += lf[(row0 + l) * 4 + h]; s_a[st] = ig[(row0 + st) * 4 + h] - bs; if (st == tl) s_misc[0] = bs; }
        __syncthreads();
        float cm = -INFINITY; for (int s = 0; s <= tl; ++s) cm = fmaxf(cm, s_a[s]);
        const float mp = mprev[unit], mm = fmaxf(cm, mp), bt = s_misc[0];
        const bf16* qrow = qb + (size_t)row * 512 + h * 128;
        { float dot = 0.f; const bf16* krow = kb + (row0 + st) * 512 + h * 128; for (int d = 0; d < 128; ++d) dot += bf2f(qrow[d]) * bf2f(krow[d]);
          s_P[st] = (st <= tl) ? dot * expf(s_a[st] - mm) : 0.f; }
        __syncthreads();
        const float inter = expf(mp - mm);
        float den = 0.f; for (int s = 0; s < 128; ++s) den += s_P[s];
        { float qn = 0.f; for (int d = 0; d < 128; ++d) qn += bf2f(qrow[d]) * nprev[(size_t)unit * 128 + d]; den += inter * qn; }
        const float dn = fmaxf(fabsf(den), expf(-(bt + mm)));
        float hv0, hv1;
        { const int e = st; float num = 0.f; for (int s = 0; s <= tl; ++s) num += s_P[s] * bf2f(vb[(row0 + s) * 1024 + h * 256 + e]);
          float qc = 0.f; const bf16* crow = CT + ((size_t)unit * 256 + e) * 128; for (int d = 0; d < 128; ++d) qc += bf2f(qrow[d]) * bf2f(crow[d]); hv0 = (num + inter * qc) / dn; }
        { const int e = st + 128; float num = 0.f; for (int s = 0; s <= tl; ++s) num += s_P[s] * bf2f(vb[(row0 + s) * 1024 + h * 256 + e]);
          float qc = 0.f; const bf16* crow = CT + ((size_t)unit * 256 + e) * 128; for (int d = 0; d < 128; ++d) qc += bf2f(qrow[d]) * bf2f(crow[d]); hv1 = (num + inter * qc) / dn; }
        s_red[st] = hv0 * hv0 + hv1 * hv1;
        __syncthreads();
        float ss = 0.f; for (int i = 0; i < 128; ++i) ss += s_red[i];
        const float rn = 1.0f / sqrtf(ss * (1.0f / 256.0f) + EPS);
        { const size_t oi = (size_t)row * 1024 + h * 256 + st; ob[oi] = (bf16)f2bf(hv0 * rn * ghn[h * 256 + st] * bf2f(ob[oi])); }
        { const size_t oi = (size_t)row * 1024 + h * 256 + st + 128; ob[oi] = (bf16)f2bf(hv1 * rn * ghn[h * 256 + st + 128] * bf2f(ob[oi])); }
        __syncthreads();
    }
}
__device__ __forceinline__ void conv_phase(bf16* bg, const bf16* ub, const float* wc, int ibase, int lt) {
    for (int li = lt; li < 131072; li += 32 * NT) { const int idx = ibase + li; const int r0 = (idx >> 7) * 4, ch0 = (idx & 127) * 8, t0 = r0 & (SEQ - 1);
        const v4u z = {0u, 0u, 0u, 0u};
        v4u uu[6], bb[4];
        uu[0] = t0 >= 2 ? *(const GAS v4u*)(ub + (size_t)(r0 - 2) * D + ch0) : z; uu[1] = t0 >= 2 ? *(const GAS v4u*)(ub + (size_t)(r0 - 1) * D + ch0) : z;
#pragma unroll
        for (int i = 0; i < 4; ++i) { uu[2 + i] = *(const GAS v4u*)(ub + (size_t)(r0 + i) * D + ch0); bb[i] = *(const GAS v4u*)(bg + (size_t)(r0 + i) * D + ch0); }
        const f32x4 w0a = *(const GAS f32x4*)(wc + ch0), w0b = *(const GAS f32x4*)(wc + ch0 + 4), w1a = *(const GAS f32x4*)(wc + D + ch0), w1b = *(const GAS f32x4*)(wc + D + ch0 + 4);
        const f32x4 w2a = *(const GAS f32x4*)(wc + 2 * D + ch0), w2b = *(const GAS f32x4*)(wc + 2 * D + ch0 + 4);
#pragma unroll
        for (int i = 0; i < 4; ++i) { v4u o;
#pragma unroll
            for (int j = 0; j < 4; ++j) { const float wl0 = j < 2 ? w0a[2 * j] : w0b[2 * j - 4], wh0 = j < 2 ? w0a[2 * j + 1] : w0b[2 * j - 3], wl1 = j < 2 ? w1a[2 * j] : w1b[2 * j - 4], wh1 = j < 2 ? w1a[2 * j + 1] : w1b[2 * j - 3];
                const float wl2 = j < 2 ? w2a[2 * j] : w2b[2 * j - 4], wh2 = j < 2 ? w2a[2 * j + 1] : w2b[2 * j - 3];
                const unsigned a = uu[2 + i][j], b1 = uu[1 + i][j], c2 = uu[i][j], gg = bb[i][j];
                const float y0 = __uint_as_float(gg << 16) * (wl0 * __uint_as_float(c2 << 16) + wl1 * __uint_as_float(b1 << 16) + wl2 * __uint_as_float(a << 16));
                const float y1 = __uint_as_float(gg & 0xffff0000u) * (wh0 * __uint_as_float(c2 & 0xffff0000u) + wh1 * __uint_as_float(b1 & 0xffff0000u) + wh2 * __uint_as_float(a & 0xffff0000u));
                o[j] = pk2(y0, y1); }
            *(GAS v4u*)(bg + (size_t)(r0 + i) * D + ch0) = o; }
    }
}
__device__ __forceinline__ void postnorm_naive(float* hout, bf16* xb, const float* g, float* ssq, bool last, int gw, int ngw, int lane) {
    for (int row = gw; row < M; row += ngw) {
        float* hr = hout + (size_t)row * D; bf16* xr = xb + (size_t)row * D;
        f32x4 hv[4]; float s = 0.f;
#pragma unroll
        for (int j = 0; j < 4; ++j) { hv[j] = *(const GAS f32x4*)(hr + 4 * lane + 256 * j); s += (hv[j][0] * hv[j][0] + hv[j][1] * hv[j][1]) + (hv[j][2] * hv[j][2] + hv[j][3] * hv[j][3]); }
        const float c = 1.0f / sqrtf(wave_sum(s) * (1.0f / D) + EPS); float s2 = 0.f;
#pragma unroll
        for (int j = 0; j < 4; ++j) { const int col = 4 * lane + 256 * j; const unsigned long long xw = *(const GAS unsigned long long*)(xr + col); const f32x4 gv = *(const GAS f32x4*)(g + col);
            const unsigned lo = (unsigned)xw, hi = (unsigned)(xw >> 32);
            f32x4 xn; xn[0] = __uint_as_float(lo << 16) + c * hv[j][0] * gv[0]; xn[1] = __uint_as_float(lo & 0xffff0000u) + c * hv[j][1] * gv[1];
            xn[2] = __uint_as_float(hi << 16) + c * hv[j][2] * gv[2]; xn[3] = __uint_as_float(hi & 0xffff0000u) + c * hv[j][3] * gv[3];
            const unsigned p0 = pk2(xn[0], xn[1]), p1 = pk2(xn[2], xn[3]);
            const float r0 = __uint_as_float(p0 << 16), r1 = __uint_as_float(p0 & 0xffff0000u), r2 = __uint_as_float(p1 << 16), r3 = __uint_as_float(p1 & 0xffff0000u);
            s2 += (r0 * r0 + r1 * r1) + (r2 * r2 + r3 * r3);
            *(GAS unsigned long long*)(xr + col) = (unsigned long long)p0 | ((unsigned long long)p1 << 32);
            if (last) *(GAS f32x4*)(hr + col) = xn; }
        s2 = wave_sum(s2);
        if (lane == 0) *(GAS f32x4*)(ssq + (size_t)row * 4) = (f32x4){s2, 0.f, 0.f, 0.f};
    }
}


typedef short s16x4 __attribute__((ext_vector_type(4)));
typedef short v4i16_t __attribute__((ext_vector_type(4)));
typedef unsigned u32x2v __attribute__((ext_vector_type(2)));
__device__ __forceinline__ s16x4 tr16(LAS const unsigned char* p) { return __builtin_bit_cast(s16x4, __builtin_amdgcn_ds_read_tr16_b64_v4i16((LAS v4i16_t*)p)); }
__device__ __forceinline__ bf16x8 cat8(s16x4 lo, s16x4 hi) { return (bf16x8){lo[0], lo[1], lo[2], lo[3], hi[0], hi[1], hi[2], hi[3]}; }
#define MFMA16(a, b, c) __builtin_amdgcn_mfma_f32_16x16x32_bf16(a, b, c, 0, 0, 0)
constexpr int KP = 288, VP = 544;
constexpr int LDS_KS = 0, LDS_VS = 128 * KP, LDS_SC = LDS_VS + 128 * VP;
static_assert(LDS_SC + 2048 + 4096 <= RING_BYTES, "mLSTM LDS map");
__device__ __forceinline__ float wave_incl_sum(float s, int lane) {
#pragma unroll
    for (int o = 1; o < 64; o <<= 1) { const float t = __shfl_up(s, o); if (lane >= o) s += t; }
    return s;
}
__device__ __forceinline__ float wave_incl_max(float s, int lane) {
#pragma unroll
    for (int o = 1; o < 64; o <<= 1) { const float t = __shfl_up(s, o); if (lane >= o) s = fmaxf(s, t); }
    return s;
}
__device__ __forceinline__ float wave_max(float v) {
#pragma unroll
    for (int o = 1; o < 64; o <<= 1) v = fmaxf(v, __shfl_xor(v, o));
    return v;
}
__device__ __forceinline__ void stage_load(const bf16* kbase, const bf16* vbase, v4u (&tk)[4], v4u (&tv)[8], int tl) {
    const unsigned ko = (unsigned)((tl >> 4) * 512 + (tl & 15) * 8), vo = (unsigned)((tl >> 5) * 1024 + (tl & 31) * 8);
#pragma unroll
    for (int i = 0; i < 4; ++i) tk[i] = *(const GAS v4u*)(kbase + (ko + (unsigned)(i * 32 * 512)));
#pragma unroll
    for (int i = 0; i < 8; ++i) tv[i] = *(const GAS v4u*)(vbase + (vo + (unsigned)(i * 16 * 1024)));
}
template <bool SCALE> __device__ __forceinline__ void stage_store(v4u (&tk)[4], const v4u (&tv)[8], LAS unsigned char* L, const LAS float* s_w, int tl) {
    const int r4 = tl >> 4, c8k = tl & 15, r5 = tl >> 5, c8v = tl & 31;
#pragma unroll
    for (int i = 0; i < 4; ++i) { const int r = r4 + 32 * i;
        if (SCALE) { const float w = s_w[r];
#pragma unroll
            for (int j = 0; j < 4; ++j) tk[i][j] = pk2(__uint_as_float(tk[i][j] << 16) * w, __uint_as_float(tk[i][j] & 0xffff0000u) * w); }
        *(LAS v4u*)(L + LDS_KS + r * KP + c8k * 16) = tk[i]; }
#pragma unroll
    for (int i = 0; i < 8; ++i) *(LAS v4u*)(L + LDS_VS + (r5 + 16 * i) * VP + c8v * 16) = tv[i];
}
__device__ __forceinline__ int mixer_unit(int vc, int i) { const int jj = (vc >> 3) * 4 + i; return (((vc & 7) >> 1) * 4 + (jj & 3)) * 64 + 32 * (vc & 1) + (jj >> 2); }
__device__ __forceinline__ void b1_fast(const bf16* kb, const bf16* vb, const float* ig, const float* lf, bf16* kvT, float* nloc, float* blast, float* mloc, LAS unsigned char* L, int tid, int vc) {
    LAS float* s_w = (LAS float*)(L + LDS_SC);
    for (int ui = 0; ui < 4; ++ui) { const int u = mixer_unit(vc, ui);
        const int tl = launder_i(tid);
        const int lane = tl & 63, wave = __builtin_amdgcn_readfirstlane(tl >> 6), g = lane >> 4, c16 = lane & 15, q = (lane >> 2) & 3, p = lane & 3;
        const int b = u >> 8, h = (u >> 6) & 3, c = u & 63; const size_t row0 = (size_t)b * SEQ + c * CH;
        v4u tk[4], tv[8];
        stage_load(kb + row0 * 512 + h * 128, vb + row0 * 1024 + h * 256, tk, tv, tl);
        if (wave == 0) {
            const float* lfp = lf + row0 * 4 + h; const float* igp = ig + row0 * 4 + h;
            const float x0 = lfp[8 * lane], x1 = lfp[8 * lane + 4], i0 = igp[8 * lane], i1 = igp[8 * lane + 4];
            const float sc = wave_incl_sum(x0 + x1, lane), ex = sc - (x0 + x1), b0 = ex + x0, b1 = sc, bl = __int_as_float(__builtin_amdgcn_readlane(__float_as_int(sc), 63));
            const float lw0 = bl - b0 + i0, lw1 = bl - b1 + i1, mx = wave_max(fmaxf(lw0, lw1));
            s_w[2 * lane] = expf(lw0 - mx); s_w[2 * lane + 1] = expf(lw1 - mx);
            if (lane == 0) { blast[u * 32] = bl; mloc[u * 32] = mx; }
        }
        __syncthreads();
        stage_store<true>(tk, tv, L, s_w, tl);
        __syncthreads();
        const short one = (c16 == 0) ? (short)0x3F80 : (short)0; const bf16x8 ones = {one, one, one, one, one, one, one, one};
        f32x4 acc[8][2], accn = {0.f, 0.f, 0.f, 0.f};
#pragma unroll
        for (int dt = 0; dt < 8; ++dt) { acc[dt][0] = (f32x4){0.f, 0.f, 0.f, 0.f}; acc[dt][1] = (f32x4){0.f, 0.f, 0.f, 0.f}; }
        const LAS unsigned char* vbp = L + LDS_VS + (4 * g + q) * VP + (32 * wave + 4 * p) * 2;
        const LAS unsigned char* kbp = L + LDS_KS + (4 * g + q) * KP + (4 * p) * 2;
#pragma unroll
        for (int ks = 0; ks < 4; ++ks) { bf16x8 vf[2];
#pragma unroll
            for (int et = 0; et < 2; ++et) { const LAS unsigned char* bp = vbp + 32 * ks * VP + 32 * et; vf[et] = cat8(tr16(bp), tr16(bp + 16 * VP)); }
#pragma unroll
            for (int dt = 0; dt < 8; ++dt) { const LAS unsigned char* bp = kbp + 32 * ks * KP + 32 * dt; const bf16x8 kf = cat8(tr16(bp), tr16(bp + 16 * KP));
                acc[dt][0] = MFMA16(kf, vf[0], acc[dt][0]); acc[dt][1] = MFMA16(kf, vf[1], acc[dt][1]); }
        }
#pragma unroll
        for (int ks = 0; ks < 4; ++ks) { const LAS unsigned char* bp = kbp + 32 * ks * KP + 32 * wave; accn = MFMA16(cat8(tr16(bp), tr16(bp + 16 * KP)), ones, accn); }
        bf16* kvu = kvT + (size_t)u * 32768; const unsigned so = (unsigned)((8 * wave * 64 + 16 * (g >> 1) + c16) * 8 + 4 * (g & 1));
#pragma unroll
        for (int dt = 0; dt < 8; ++dt)
#pragma unroll
            for (int et = 0; et < 2; ++et) { u32x2v w; w.x = pk2(acc[dt][et][0], acc[dt][et][1]); w.y = pk2(acc[dt][et][2], acc[dt][et][3]);
                *(GAS u32x2v*)(kvu + (so + (unsigned)(((et * 4 + (dt >> 1)) * 64 + 32 * (dt & 1)) * 8))) = w; }
        if (c16 == 0) *(GAS f32x4*)(nloc + (size_t)u * 128 + 16 * wave + 4 * g) = accn;
        __syncthreads();
    }
}
__device__ __forceinline__ void b2_fast(const bf16* kvT, bf16* CT, const float* nloc, bf16* NPB, const float* blast, const float* mloc, float* mprev, LAS unsigned char* L, int tid, int item0, int G) {
    LAS float* s_a = (LAS float*)L; LAS float* s_s = s_a + 64; LAS float* s_bl = s_a + 128; LAS float* s_ml = s_a + 192;
    for (int item = item0; item < 256; item += G) { const int bh = item >> 4, part = item & 15;
        if (tid < 64) {
            const float bl = blast[(bh * 64 + tid) * 32], ml = mloc[(bh * 64 + tid) * 32]; float A = bl, B = ml;
#pragma unroll
            for (int o = 1; o < 64; o <<= 1) { const float Ap = __shfl_up(A, o), Bp = __shfl_up(B, o); if (tid >= o) { B = fmaxf(Bp + A, B); A = Ap + A; } }
            const float mn = fmaxf(A, B);
            float m = __shfl_up(mn, 1); if (tid == 0) m = 0.f;
            s_a[tid] = expf(bl + m - mn); s_s[tid] = expf(ml - mn); if (part == 0) mprev[bh * 64 + tid] = m; }
        __syncthreads();
        if (tid < 256) {
            const size_t off = (size_t)bh * 64 * 32768 + part * 2048 + tid * 8;
            float C[8];
#pragma unroll
            for (int j = 0; j < 8; ++j) C[j] = 0.f;
            for (int c0 = 0; c0 < NCH; c0 += 16) {
                v4u kvb[16];
#pragma unroll
                for (int i = 0; i < 16; ++i) kvb[i] = *(const GAS v4u*)(kvT + off + (size_t)(c0 + i) * 32768);
#pragma unroll
                for (int i = 0; i < 16; ++i) { const int c = c0 + i; const v4u kv = kvb[i];
                    v4u o; o.x = pk2(C[0], C[1]); o.y = pk2(C[2], C[3]); o.z = pk2(C[4], C[5]); o.w = pk2(C[6], C[7]); *(GAS v4u*)(CT + off + (size_t)c * 32768) = o;
                    const float a = s_a[c], sv = s_s[c];
#pragma unroll
                    for (int j = 0; j < 4; ++j) { C[2 * j] = a * C[2 * j] + sv * __uint_as_float(kv[j] << 16); C[2 * j + 1] = a * C[2 * j + 1] + sv * __uint_as_float(kv[j] & 0xffff0000u); } } }
        } else if (part == 0 && tid < 384) { const int d = tid - 256; float n = 0.f;
            for (int c0 = 0; c0 < NCH; c0 += 16) { float nl[16];
#pragma unroll
                for (int i = 0; i < 16; ++i) nl[i] = nloc[(size_t)(bh * 64 + c0 + i) * 128 + d];
#pragma unroll
                for (int i = 0; i < 16; ++i) { const int c = c0 + i; NPB[(size_t)(bh * 64 + c) * 128 + d] = (bf16)f2bf(n); n = s_a[c] * n + s_s[c] * nl[i]; } } }
        __syncthreads();
    }
}
__device__ __forceinline__ void b3_fast(const bf16* qb, const bf16* kb, const bf16* vb, bf16* ob, const bf16* CT, const bf16* NPB, const float* mprev, const float* ig, const float* lf, const float* ghn,
                                        LAS unsigned char* L, int tid, int vc) {
    LAS float* s_a = (LAS float*)(L + LDS_SC); LAS float* s_mm = s_a + 128; LAS float* s_bm = s_a + 256;
    LAS float* s_gh = (LAS float*)(L + LDS_SC + 2048);
    for (int i = tid; i < 256; i += NT) *(LAS f32x4*)(s_gh + 4 * i) = *(const GAS f32x4*)(ghn + 4 * i);
    v4u tk[4], tv[8]; bf16x8 qn[4]; float px0 = 0.f, px1 = 0.f, pi0 = 0.f, pi1 = 0.f;
#define B3_PREFETCH(un) do { const int tl_ = launder_i(tid); const int b_ = (un) >> 8, h_ = ((un) >> 6) & 3, c_ = (un) & 63; const size_t r_ = (size_t)b_ * SEQ + c_ * CH; \
        stage_load(kb + r_ * 512 + h_ * 128, vb + r_ * 1024 + h_ * 256, tk, tv, tl_); \
        { const bf16* qbase_ = qb + r_ * 512 + h_ * 128; const unsigned qo_ = (unsigned)((16 * (tl_ >> 6) + (tl_ & 15)) * 512 + 8 * ((tl_ & 63) >> 4)); \
          _Pragma("unroll") for (int ks = 0; ks < 4; ++ks) qn[ks] = *(const GAS bf16x8*)(qbase_ + (qo_ + 32u * ks)); } \
        if (tl_ < 64) { const float* lfp_ = lf + r_ * 4 + h_; const float* igp_ = ig + r_ * 4 + h_; px0 = lfp_[8 * tl_]; px1 = lfp_[8 * tl_ + 4]; pi0 = igp_[8 * tl_]; pi1 = igp_[8 * tl_ + 4]; } } while (0)
    { const int u_first = mixer_unit(vc, 3); B3_PREFETCH(u_first); }
    for (int ui = 3; ui >= 0; --ui) { const int u = mixer_unit(vc, ui);
        const int tl = launder_i(tid);
        const int lane = tl & 63, wave = __builtin_amdgcn_readfirstlane(tl >> 6), g = lane >> 4, c16 = lane & 15, q = (lane >> 2) & 3, p = lane & 3;
        const int b = u >> 8, h = (u >> 6) & 3, c = u & 63; const size_t row0 = (size_t)b * SEQ + c * CH;
        const float mp = mprev[u];
        const int t = 16 * wave + c16;
        bf16x8 qf[4];
#pragma unroll
        for (int ks = 0; ks < 4; ++ks) qf[ks] = qn[ks];
        const bf16* ctb = CT + (size_t)u * 32768; const unsigned coff = (unsigned)(lane * 8);
        bf16x8 cf[3][4];
#pragma unroll
        for (int pe = 0; pe < 2; ++pe)
#pragma unroll
            for (int ks = 0; ks < 4; ++ks) cf[pe][ks] = *(const GAS bf16x8*)(ctb + (coff + (unsigned)((pe * 4 + ks) * 512)));
        if (wave == 0) {
            const float x0 = px0, x1 = px1, i0 = pi0, i1 = pi1;
            const float sc = wave_incl_sum(x0 + x1, lane), ex = sc - (x0 + x1), b0 = ex + x0, b1 = sc;
            const float a0 = i0 - b0, a1 = i1 - b1, cmx = wave_incl_max(fmaxf(a0, a1), lane);
            float pe = __shfl_up(cmx, 1); if (lane == 0) pe = -INFINITY;
            const float mm0 = fmaxf(fmaxf(pe, a0), mp), mm1 = fmaxf(cmx, mp);
            s_a[2 * lane] = a0; s_a[2 * lane + 1] = a1; s_mm[2 * lane] = mm0; s_mm[2 * lane + 1] = mm1; s_bm[2 * lane] = b0 + mm0; s_bm[2 * lane + 1] = b1 + mm1;
        }
        stage_store<false>(tk, tv, L, nullptr, tl);
        __syncthreads();
        const float mm_t = s_mm[t], bm_t = s_bm[t], inter_t = expf(mp - mm_t);
        const short one = (c16 == 0) ? (short)0x3F80 : (short)0; const bf16x8 ones = {one, one, one, one, one, one, one, one};
        f32x4 acc[16], accn = {0.f, 0.f, 0.f, 0.f};
#pragma unroll
        for (int et = 0; et < 16; ++et) acc[et] = (f32x4){0.f, 0.f, 0.f, 0.f};
#pragma unroll
        for (int et = 0; et < 16; ++et) {
            if (et + 2 < 16) {
#pragma unroll
                for (int ks = 0; ks < 4; ++ks) cf[(et + 2) % 3][ks] = *(const GAS bf16x8*)(ctb + (coff + (unsigned)(((et + 2) * 4 + ks) * 512))); }
#pragma unroll
            for (int ks = 0; ks < 4; ++ks) acc[et] = MFMA16(cf[et % 3][ks], qf[ks], acc[et]);
        }
        bf16* obase = ob + (row0 + 16 * wave) * 1024 + h * 256; const unsigned oo = (unsigned)((lane >> 5) * 1024 + (lane & 31) * 8);
        v4u sg[8];
#pragma unroll
        for (int i = 0; i < 8; ++i) sg[i] = *(const GAS v4u*)(obase + (oo + 2048u * i));
        { const bf16* npb = NPB + (size_t)u * 128;
#pragma unroll
          for (int ks = 0; ks < 4; ++ks) { bf16x8 nf = *(const GAS bf16x8*)(npb + (32 * ks + 8 * g)); if (c16 != 0) nf = (bf16x8){0, 0, 0, 0, 0, 0, 0, 0}; accn = MFMA16(nf, qf[ks], accn); } }
#pragma unroll
        for (int et = 0; et < 16; ++et) acc[et] = acc[et] * inter_t;
        accn = accn * inter_t;
        if (ui > 0) { const int un = mixer_unit(vc, ui - 1); B3_PREFETCH(un); }
        const LAS unsigned char* kbp = L + LDS_KS + c16 * KP + 16 * g;
        const LAS unsigned char* vbp = L + LDS_VS + (4 * g + q) * VP + 8 * p;
        for (int ss = 0; ss <= (wave >> 1); ++ss) { const int s0 = 32 * ss;
            f32x4 X0 = {0.f, 0.f, 0.f, 0.f}, X1 = {0.f, 0.f, 0.f, 0.f};
#pragma unroll
            for (int ks = 0; ks < 4; ++ks) { const bf16x8 k0f = *(const LAS bf16x8*)(kbp + s0 * KP + 64 * ks), k1f = *(const LAS bf16x8*)(kbp + (s0 + 16) * KP + 64 * ks);
                X0 = MFMA16(k0f, qf[ks], X0); X1 = MFMA16(k1f, qf[ks], X1); }
            const f32x4 a40 = *(const LAS f32x4*)(s_a + s0 + 4 * g), a41 = *(const LAS f32x4*)(s_a + s0 + 16 + 4 * g);
            float P0[4], P1[4];
#pragma unroll
            for (int r = 0; r < 4; ++r) { const int s = s0 + 4 * g + r; P0[r] = (s <= t) ? X0[r] * __expf(a40[r] - mm_t) : 0.f; P1[r] = (s + 16 <= t) ? X1[r] * __expf(a41[r] - mm_t) : 0.f;   }
            v4u pw; pw.x = pk2(P0[0], P0[1]); pw.y = pk2(P0[2], P0[3]); pw.z = pk2(P1[0], P1[1]); pw.w = pk2(P1[2], P1[3]);
            const bf16x8 pf = __builtin_bit_cast(bf16x8, pw);
#pragma unroll
            for (int et = 0; et < 16; ++et) { const LAS unsigned char* bp = vbp + s0 * VP + 32 * et; const bf16x8 vf = cat8(tr16(bp), tr16(bp + 16 * VP)); acc[et] = MFMA16(vf, pf, acc[et]); }
            accn = MFMA16(ones, pf, accn);
        }
        const float den = __shfl(accn[0], c16), dn = fmaxf(fabsf(den), expf(-bm_t)), inv = 1.0f / dn;
        float ssq = 0.f;
#pragma unroll
        for (int et = 0; et < 16; ++et) { acc[et] = acc[et] * inv; ssq += (acc[et][0] * acc[et][0] + acc[et][1] * acc[et][1]) + (acc[et][2] * acc[et][2] + acc[et][3] * acc[et][3]); }
        ssq += __shfl_xor(ssq, 16); ssq += __shfl_xor(ssq, 32);
        const float rn = 1.0f / sqrtf(ssq * (1.0f / 256.0f) + EPS);
        __syncthreads();
        LAS unsigned char* ost = L + LDS_VS + wave * (16 * 528);
#pragma unroll
        for (int et = 0; et < 16; ++et) { const f32x4 gh = *(const LAS f32x4*)(s_gh + h * 256 + 16 * et + 4 * g);
            u32x2v w; w.x = pk2(acc[et][0] * rn * gh[0], acc[et][1] * rn * gh[1]); w.y = pk2(acc[et][2] * rn * gh[2], acc[et][3] * rn * gh[3]);
            *(LAS u32x2v*)(ost + c16 * 528 + (16 * et + 4 * g) * 2) = w; }
        LDS_WAIT(); asm volatile("" ::: "memory");
#pragma unroll
        for (int i = 0; i < 8; ++i) { const v4u hv = *(const LAS v4u*)(ost + ((lane >> 5) + 2 * i) * 528 + (lane & 31) * 16); v4u o;
#pragma unroll
            for (int j = 0; j < 4; ++j) o[j] = pk2(__uint_as_float(hv[j] << 16) * __uint_as_float(sg[i][j] << 16), __uint_as_float(hv[j] & 0xffff0000u) * __uint_as_float(sg[i][j] & 0xffff0000u));
            *(GAS v4u*)(obase + (oo + 2048u * i)) = o; }
        __syncthreads();
    }
#undef B3_PREFETCH
}
__device__ __forceinline__ void gates_fast(const bf16* xb, const bf16* wgT, const float* bias, const float* ssq, float* ig, float* lf, int gw, int ngw, int lane) {
    const int g = lane >> 4, c16 = lane & 15;
    for (int tile = gw; tile < M / 16; tile += ngw) { const size_t row = (size_t)tile * 16 + c16; f32x4 acc = {0.f, 0.f, 0.f, 0.f};
#pragma unroll 8
        for (int ks = 0; ks < 32; ++ks) { const bf16x8 wf = *(const GAS bf16x8*)(wgT + c16 * D + 32 * ks + 8 * g), xf = *(const GAS bf16x8*)(xb + row * D + 32 * ks + 8 * g); acc = MFMA16(wf, xf, acc); }
        const float rs = 1.0f / sqrtf(((ssq[row] + ssq[M + row]) + (ssq[2 * M + row] + ssq[3 * M + row])) * (1.0f / D) + EPS);
        if (g < 2) { f32x4 o;
#pragma unroll
            for (int r = 0; r < 4; ++r) { float v = acc[r] * rs + bias[4 * g + r]; v = GATE_CAP * tanhf(v * (1.0f / GATE_CAP)); o[r] = (g == 0) ? v : (fminf(v, 0.f) - log1pf(expf(-fabsf(v)))); }
            *(GAS f32x4*)((g == 0 ? ig : lf) + row * 4) = o; }
    }
}

#define XB_LSUB(j)  (3520 + 64 * (j))
#define XB_LGEN(j)  (4544 + 64 * (j))
__device__ __forceinline__ XcdBarrier xcd_barrier_post_rank(unsigned* bar, volatile LAS unsigned* st, volatile LAS unsigned* rank_word, unsigned wv) {
    XcdBarrier b; b.wv = wv; b.bar = bar; b.x = xb_xcc_id(); b.st = st;
    if (XB_T0(b)) *rank_word = xb_add(&bar[XB_XCNT(b.x)], 1u);
    return b;
}
#define XB_LSLOT(j) (8192 + 32 * (j))
__device__ __forceinline__ void xcd_local_barrier(const XcdBarrier& b, volatile LAS unsigned* rankw, volatile LAS unsigned* genw) {
    asm volatile("s_waitcnt vmcnt(0)" ::: "memory");
    __syncthreads();
    if (b.wv == 0u) {
        unsigned* line = b.bar + XB_LSLOT(b.x); const unsigned l = xb_lane_now();
        const unsigned rank = (unsigned)__builtin_amdgcn_readfirstlane((int)*rankw), gen = (unsigned)__builtin_amdgcn_readfirstlane((int)*genw) + 1u;
        __builtin_amdgcn_s_waitcnt(0);
        if (l == 0u) { *genw = gen; __hip_atomic_store(line + rank, gen, __ATOMIC_RELAXED, __HIP_MEMORY_SCOPE_WORKGROUP); }
        unsigned sp = 0u;
        for (;;) {
            const unsigned v = __hip_atomic_load(line + (l & 31u), __ATOMIC_RELAXED, __HIP_MEMORY_SCOPE_AGENT);
            if (__builtin_amdgcn_ballot_w64((int)(v - gen) >= 0) == ~0ull) break;
            __builtin_amdgcn_s_sleep(1);
            if ((++sp & 255u) == 0u) { if (xb_ld(&b.bar[XB_TMO])) break; if (sp > XB_SPIN_CAP) { atomicAdd(&b.bar[XB_TMO], 1u); break; } } }
        __builtin_amdgcn_fence(__ATOMIC_ACQUIRE, "agent");
        asm volatile("s_waitcnt vmcnt(0)" ::: "memory");
    }
    __syncthreads();
}
#define XB_GSLOT(j) (8448 + 32 * (j))
#define XB_GREL(j)  (8704 + 32 * (j))
#define XB_WDONE    9728
#define XB_PTOP(p)  (9216 + 64 * (p))
#define XB_PGEN(p)  (9472 + 64 * (p))
__device__ __forceinline__ void xcd_pair_barrier(const XcdBarrier& b, volatile LAS unsigned* rankw, volatile LAS unsigned* genw) {
    asm volatile("s_waitcnt vmcnt(0)" ::: "memory");
    __syncthreads();
    if (b.wv == 0u) {
        unsigned* bar = b.bar; unsigned* line = bar + XB_GSLOT(b.x); unsigned* rel = bar + XB_GREL(b.x); const unsigned l = xb_lane_now();
        const unsigned rank = (unsigned)__builtin_amdgcn_readfirstlane((int)*rankw), gen = (unsigned)__builtin_amdgcn_readfirstlane((int)*genw) + 1u;
        __builtin_amdgcn_s_waitcnt(0);
        if (l == 0u) { *genw = gen; __hip_atomic_store(line + rank, gen, __ATOMIC_RELAXED, __HIP_MEMORY_SCOPE_WORKGROUP); }
        unsigned sp = 0u;
        if (rank == 0u) {
            for (;;) {
                const unsigned v = __hip_atomic_load(line + (l & 31u), __ATOMIC_RELAXED, __HIP_MEMORY_SCOPE_AGENT);
                if (__builtin_amdgcn_ballot_w64((int)(v - gen) >= 0) == ~0ull) break;
                __builtin_amdgcn_s_sleep(1);
                if ((++sp & 255u) == 0u) { if (xb_ld(&bar[XB_TMO])) break; if (sp > XB_SPIN_CAP) { atomicAdd(&bar[XB_TMO], 1u); break; } } }
            __builtin_amdgcn_fence(__ATOMIC_RELEASE, "agent");
            asm volatile("s_waitcnt vmcnt(0)" ::: "memory");
            if (l == 0u) { const unsigned pr = b.x >> 1, og = xb_add(&bar[XB_PTOP(pr)], 1u), tg = og / 2u;
                if (og + 1u == (tg + 1u) * 2u) xb_add(&bar[XB_PGEN(pr)], 1u);
                else XB_SPIN(xb_ld(&bar[XB_PGEN(pr)]) == tg, bar); }
            __builtin_amdgcn_fence(__ATOMIC_ACQUIRE, "agent");
            if (l == 0u) __hip_atomic_store(rel, gen, __ATOMIC_RELAXED, __HIP_MEMORY_SCOPE_WORKGROUP);
            asm volatile("s_waitcnt vmcnt(0)" ::: "memory");
        } else {
            for (;;) {
                const unsigned v = __hip_atomic_load(rel, __ATOMIC_RELAXED, __HIP_MEMORY_SCOPE_AGENT);
                if ((int)((unsigned)__builtin_amdgcn_readfirstlane((int)v) - gen) >= 0) break;
                __builtin_amdgcn_s_sleep(1);
                if ((++sp & 255u) == 0u) { if (xb_ld(&bar[XB_TMO])) break; if (sp > XB_SPIN_CAP) { atomicAdd(&bar[XB_TMO], 1u); break; } } }
            __builtin_amdgcn_fence(__ATOMIC_ACQUIRE, "agent");
            asm volatile("s_waitcnt vmcnt(0)" ::: "memory");
        }
    }
    __syncthreads();
}
#define BSEL_() ({ int t_ = bsel; asm volatile("" : "+s"(t_)); (size_t)t_; })
#define SP_(OFFC, OFFB, ROWB) ((bf16*)(ws + WS_S + (xmode ? (size_t)(OFFB) : (size_t)(OFFC)) + BSEL_() * (size_t)(80 * MiB - (size_t)(ROWB))))
#define hid SP_(0, 0, (size_t)SEQ * FF * 2)
#define qb  SP_(0, 0, (size_t)SEQ * 512 * 2)
#define kb  SP_(32 * MiB, 8 * MiB, (size_t)SEQ * 512 * 2)
#define vb  SP_(64 * MiB, 16 * MiB, (size_t)SEQ * 1024 * 2)
#define ob  SP_(128 * MiB, 32 * MiB, (size_t)SEQ * 1024 * 2)
#define kvT SP_(192 * MiB, 48 * MiB, (size_t)NH * NCH * 32768 * 2)
#define CT  SP_(256 * MiB, 64 * MiB, (size_t)NH * NCH * 32768 * 2)
#define bgb SP_(0, 0, (size_t)SEQ * 1024 * 2)
#define ub  SP_(64 * MiB, 16 * MiB, (size_t)SEQ * 1024 * 2)
__global__ void __launch_bounds__(NT, 2) mk_fwd(Args args) {
    extern __shared__ __attribute__((aligned(16))) unsigned char lds[];
    LAS unsigned char* L = (LAS unsigned char*)lds;
    volatile LAS unsigned* MISC = (volatile LAS unsigned*)(L + MISC_OFF);
    const int tid = threadIdx.x, lane = tid & 63, wave = __builtin_amdgcn_readfirstlane(tid >> 6), G = gridDim.x;
    const int gtid = blockIdx.x * NT + tid, gthreads = G * NT, gw = blockIdx.x * NWAVES + wave, ngw = G * NWAVES;
    unsigned char* ws = args.ws;
    gu32* ctl = (gu32*)(ws + WS_CTL);
    const float* x_in = args.in[0]; const float* norm_g = args.in[1]; const float* w_in_m = args.in[2]; const float* b_gates = args.in[3]; const float* g_hnorm = args.in[4];
    const float* w_out_m = args.in[5]; const float* w_in_c = args.in[6]; const float* w_conv = args.in[7]; const float* w_out_c = args.in[8]; const float* w_up = args.in[9]; const float* w_dn = args.in[10];
    float* ssq = (float*)(ws + WS_SSQ); float* igp = (float*)(ws + WS_IG); float* lfp = (float*)(ws + WS_LF);
    float* blast = (float*)(ws + WS_BLAST); float* mloc = (float*)(ws + WS_MLOC); float* mprev = (float*)(ws + WS_MPREV);
    float* nloc = (float*)(ws + WS_NLOC); float* nprev = (float*)(ws + WS_NPREV); bf16* NPB = (bf16*)(ws + WS_NPREV); bf16* wgT = (bf16*)(ws + WS_WGT);
    bf16* xb = (bf16*)(ws + WS_XB);
    for (int u = tid; u < (LDS_BYTES - LDSCTL_OFF) / 4; u += NT) ((LAS unsigned*)(L + LDSCTL_OFF))[u] = 0u;
    __syncthreads();
#define TIDN (wave * 64 + (int)xb_lane_now())
    const int lo = args.lo, hi = args.hi;
    XcdBarrier bar; bar.wv = (unsigned)wave; bar.bar = (unsigned*)(ctl + CW_BAR); bar.x = 0; bar.st = nullptr;
    if (!args.multi) bar = xcd_barrier_post_rank((unsigned*)(ctl + CW_BAR), MISC + 8, MISC + 12, (unsigned)wave);
#define IN(id) (lo <= (id) && (id) < hi)
    unsigned long long pr_acc = 0ull, pr_t0 = 0ull, pr_dummy = 0ull;
#define PRE(sitecls) ((PROBE_CLASS == 21 || PROBE_CLASS == (sitecls)) ? pr_acc : pr_dummy)
#define PSTART(cls) do { if (PROBE_CLASS == (cls)) pr_t0 = wall_clock64(); } while (0)
#define PEND(cls) do { if (PROBE_CLASS == (cls)) pr_acc += wall_clock64() - pr_t0; } while (0)
    int vc = (int)blockIdx.x, xmode = 0, bsel = 0;
#define SEAML(id) do { if (hi > (id) + 1) { PSTART(10); XcdBarrier bl_ = bar; asm volatile("" : "+s"(bl_.bar)); if (xmode) xcd_local_barrier(bl_, MISC + 12, MISC + 14); else xcd_barrier(bl_); PEND(10); } } while (0)
#define SEAM(id) do { if (hi > (id) + 1) { PSTART(10); XcdBarrier bl_ = bar; asm volatile("" : "+s"(bl_.bar)); if (xmode) xcd_pair_barrier(bl_, MISC + 12, MISC + 15); else xcd_barrier(bl_); PEND(10); } } while (0)

    if (IN(PH_PRO)) {
        PSTART(0);
        LAS float* scr = (LAS float*)(L + RING_OFF + wave * 16384);
        constexpr int I_IN = 16 * 96, I_OUT = 16 * 32, I_UP = 16 * 128, I_DN = 64 * 32, I_LAYER = I_IN + I_OUT + I_UP + I_DN;
        auto decode = [&](int it) -> P0Item {
            const int Ly = it / I_LAYER, j = Ly >> 1; int r = it % I_LAYER; const float* g = norm_g + (size_t)Ly * 4 * D;
            bf16* wl = (bf16*)(ws + WS_W + (size_t)Ly * W_LAYER); P0Item I;
            if (r < I_IN) { const int kb_ = r / 96, n0 = (r % 96) * 32;
                if (!(Ly & 1)) I = P0Item{w_in_m + (size_t)j * D * MIN_COLS, g, wl + W_IN / 2, MIN_COLS, n0, kb_ * 64, D, n0, (n0 >= 512 && n0 < 1024) ? 0.08838834764831845f : 1.0f};
                else { int src; if (n0 < 2048) { const int pn = n0 >> 8, within = n0 & 255; src = within < 128 ? 1024 + 128 * pn + within : 2048 + 128 * pn + (within - 128); } else src = n0 - 2048;
                    I = P0Item{w_in_c + (size_t)j * D * 3072, g, wl + W_IN / 2, 3072, src, kb_ * 64, D, n0, 1.0f}; }
                return I; } r -= I_IN;
            if (r < I_OUT) { const int kb_ = r / 32, nb = r % 32; return P0Item{((Ly & 1) ? w_out_c : w_out_m) + (size_t)j * D * D, nullptr, wl + W_OUT / 2, D, nb * 32, kb_ * 64, D, nb * 32, 1.0f}; } r -= I_OUT;
            if (r < I_UP) { const int kb_ = r / 128, nb = r % 128; return P0Item{w_up + (size_t)Ly * D * FF, g + 2 * D, wl + W_UP / 2, FF, nb * 32, kb_ * 64, D, nb * 32, 1.0f}; } r -= I_UP;
            { const int kb_ = r / 32, nb = r % 32; return P0Item{w_dn + (size_t)Ly * FF * D, nullptr, wl + W_DN / 2, D, nb * 32, kb_ * 64, FF, nb * 32, 1.0f}; }
        };
        static_assert((DEPTH * I_LAYER) % 2 == 0 && I_IN % 2 == 0, "items are taken in pairs");
        constexpr int P1_PAIRS = (DEPTH * I_LAYER - I_IN) / 2;
        PSTART(12);
        for (int it = gw; it < I_IN / 2; it += ngw) {
            const P0Item Ia = decode(it), Ib = decode(it + I_IN / 2); float va_[32], vb_[32];
            p0_load(Ia, va_, lane); p0_load(Ib, vb_, lane);
            p0_finish(Ia, va_, scr, lane); p0_finish(Ib, vb_, scr, lane);
        }
        PEND(12);
        for (int idx = gtid; idx < 2 * 16 * D; idx += gthreads) { const int jl = idx >> 14, jg = (idx >> 10) & 15, k = idx & 1023;
            wgT[idx] = (jg < 8) ? (bf16)f2bf(w_in_m[((size_t)jl * D + k) * MIN_COLS + 3072 + jg] * norm_g[(size_t)(2 * jl) * 4 * D + k]) : (bf16)0; }
        for (int r0 = gw * 4; r0 < M; r0 += ngw * 4) {
            f32x4 v[4][4];
#pragma unroll
            for (int i = 0; i < 4; ++i)
#pragma unroll
                for (int j = 0; j < 4; ++j) v[i][j] = *(const GAS f32x4*)(x_in + (size_t)(r0 + i) * D + 4 * lane + 256 * j);
            float s2r[4];
#pragma unroll
            for (int i = 0; i < 4; ++i) { bf16* orow = xb + (size_t)(r0 + i) * D; float s2 = 0.f;
#pragma unroll
                for (int j = 0; j < 4; ++j) { const unsigned p0 = pk2(v[i][j][0], v[i][j][1]), p1 = pk2(v[i][j][2], v[i][j][3]);
                    const float q0 = __uint_as_float(p0 << 16), q1 = __uint_as_float(p0 & 0xffff0000u), q2 = __uint_as_float(p1 << 16), q3 = __uint_as_float(p1 & 0xffff0000u);
                    s2 += (q0 * q0 + q1 * q1) + (q2 * q2 + q3 * q3); *(GAS unsigned long long*)(orow + 4 * lane + 256 * j) = (unsigned long long)p0 | ((unsigned long long)p1 << 32); }
                s2r[i] = wave_sum(s2); }
            if (lane < 4) { const float val = lane == 0 ? s2r[0] : lane == 1 ? s2r[1] : lane == 2 ? s2r[2] : s2r[3];
                ssq[r0 + lane] = val; ssq[M + r0 + lane] = 0.f; ssq[2 * M + r0 + lane] = 0.f; ssq[3 * M + r0 + lane] = 0.f; }
        }
        for (int idx = gtid; idx < 4 * M; idx += gthreads) ((unsigned long long*)(ws + WS_XG))[idx] = 0ull;
        PEND(0);
        SEAM(PH_PRO);
        if (!MK_MULTI) {
            if (TIDN == 0) { unsigned ok = (G == 256) ? 1u : 0u; const unsigned* bw = (const unsigned*)(ctl + CW_BAR);
#pragma unroll
                for (unsigned jx = 0; jx < 16; ++jx) { const unsigned cx = xb_ld((unsigned*)&bw[XB_XCNT(jx)]); ok &= (cx == (jx < 8u ? 32u : 0u)) ? 1u : 0u; }
                MISC[13] = ok; }
            __syncthreads();
            xmode = __builtin_amdgcn_readfirstlane((int)MISC[13]);
            if (xmode) { vc = __builtin_amdgcn_readfirstlane((int)MISC[12]) * 8 + (int)bar.x; bsel = (int)(bar.x >> 1); }
        }
        { int q0 = gw, q1 = P1_PAIRS, qs = ngw;
            if (xmode) { const int p = bsel; q0 = P1_PAIRS / 6 * (p * (p - 1) / 2) + (((vc & 1) * 32 + (vc >> 3)) * NWAVES + wave); q1 = (p == 3) ? P1_PAIRS : P1_PAIRS / 6 * (p * (p + 1) / 2); qs = 64 * NWAVES; if (p == 0) q1 = 0; }
            PSTART(12);
            for (int q = q0; q < q1; q += qs) {
                const P0Item Ia = decode(I_IN + q), Ib = decode(I_IN + P1_PAIRS + q); float va_[32], vb_[32];
                p0_load(Ia, va_, lane); p0_load(Ib, vb_, lane);
                p0_finish(Ia, va_, scr, lane); p0_finish(Ib, vb_, scr, lane);
            }
            PEND(12);
            if (xmode) { if (bsel != 0) { asm volatile("s_waitcnt vmcnt(0)" ::: "memory"); __syncthreads();
                    if (TIDN == 0) { __builtin_amdgcn_fence(__ATOMIC_RELEASE, "agent"); asm volatile("s_waitcnt vmcnt(0)" ::: "memory"); (void)xb_add((unsigned*)(ctl + CW_BAR) + XB_WDONE, 1u); } } }
            else SEAM(PH_PRO);
        }
    }
#define WREADY() do { if (xmode) { if (wave == 0) { unsigned* bw_ = (unsigned*)(ctl + CW_BAR); XB_SPIN(xb_ld(&bw_[XB_WDONE]) < 192u, bw_); __builtin_amdgcn_fence(__ATOMIC_ACQUIRE, "agent"); asm volatile("s_waitcnt vmcnt(0)" ::: "memory"); } \
        __syncthreads(); } } while (0)

    for (int hl = 0; hl < 2 * DEPTH; ++hl) {
        const int Ly = hl >> 1, j = Ly >> 1, pid = 1 + hl * PH_PER_HL;
        const float* g = norm_g + (size_t)Ly * 4 * D;
        const bf16* wl = (const bf16*)(ws + WS_W + (size_t)Ly * W_LAYER);
        const bf16* nA; const bf16* nB; int nK; const float* ngain;
        if (!(hl & 1)) {
            if (!(Ly & 1)) {
                if (IN(pid + 0)) {
                    PSTART(1); PSTART(11);
                    #if NAIVE_GATES
                    gates_naive(xb, w_in_m + (size_t)j * D * MIN_COLS, g, b_gates + j * 8, ssq, igp, lfp, blockIdx.x * NT + TIDN, gthreads);
#else
                    gates_fast(xb, wgT + (size_t)j * 16 * D, b_gates + j * 8, ssq, igp, lfp, (vc & 7) * 256 + (vc >> 3) * 8 + wave, M / 16, TIDN & 63);
#endif
                    PEND(11);
                    pg8::Gemm gm{xb, wl + W_IN / 2, M, 3072, D}; pg8::StaticOrder S; S.init(M, 3072, G, vc);
                    pg8::EpiMlstmIn E{qb, kb, vb, ob, ssq, (LAS float*)(L + LDSCTL_OFF + 14336)};
                    pg8::gemm_phase<pg8::EpiMlstmIn, pg8::StaticOrder, true, true>(L + RING_OFF, gm, S, E, TIDN, pr_acc, PRE(23));
                    if (hl == 0) WREADY();
                    PEND(1);
                    SEAML(pid + 0);
                }
                #if NAIVE_B1
                if (IN(pid + 1)) { b1_naive(kb, vb, igp, lfp, kvT, nloc, blast, mloc, (LAS float*)(L + RING_OFF), TIDN, G); SEAM(pid + 1); }
#else
                if (IN(pid + 1)) { PSTART(2); b1_fast(kb, vb, igp, lfp, kvT, nloc, blast, mloc, L + RING_OFF, TIDN, vc); PEND(2); SEAM(pid + 1); }
#endif
                #if NAIVE_B2
                if (IN(pid + 2)) { b2_naive(kvT, CT, nloc, nprev, blast, mloc, mprev, blockIdx.x * NT + TIDN, gthreads); SEAM(pid + 2); }
#else
                if (IN(pid + 2)) { PSTART(3); b2_fast(kvT, CT, nloc, NPB, blast, mloc, mprev, L + RING_OFF, TIDN, xmode ? 64 * ((vc & 7) >> 1) + 32 * (vc & 1) + (vc >> 3) : vc, G); PEND(3); SEAM(pid + 2); }
#endif
                #if NAIVE_B3
                if (IN(pid + 3)) { b3_naive(qb, kb, vb, ob, CT, nprev, mprev, igp, lfp, g_hnorm + (size_t)j * D, (LAS float*)(L + RING_OFF), TIDN, G); SEAM(pid + 3); }
#else
                if (IN(pid + 3)) { PSTART(4); b3_fast(qb, kb, vb, ob, CT, NPB, mprev, igp, lfp, g_hnorm + (size_t)j * D, L + RING_OFF, TIDN, vc); PEND(4); SEAML(pid + 3); }
#endif
                nA = ob;
            } else {
                if (IN(pid + 0)) {
                    PSTART(5);
                    pg8::Gemm gm{xb, wl + W_IN / 2, M, 3072, D}; pg8::StaticOrder S; S.init(M, 3072, G, vc);
                    pg8::EpiConvIn E{ub, bgb, ssq, (LAS float*)(L + LDSCTL_OFF + 14336)};
                    pg8::gemm_phase<pg8::EpiConvIn, pg8::StaticOrder, true, true>(L + RING_OFF, gm, S, E, TIDN, pr_acc, PRE(23));
                    PEND(5);
                    SEAM(pid + 0);
                }
                if (IN(pid + 1)) { PSTART(6); conv_phase(bgb, ub, w_conv + (size_t)j * 3 * D, (vc & 7) * 131072, (vc >> 3) * NT + TIDN); PEND(6); SEAML(pid + 1); }
                nA = bgb;
            }
            nB = wl + W_OUT / 2; nK = D; ngain = g + D;
        } else {
            if (IN(pid + 0)) {
                PSTART(8);
                pg8::Gemm gm{xb, wl + W_UP / 2, M, FF, D}; pg8::StaticOrder S; S.init(M, FF, G, vc);
                pg8::EpiUp E{hid, ssq, (LAS float*)(L + LDSCTL_OFF + 14336)};
                pg8::gemm_phase<pg8::EpiUp, pg8::StaticOrder, true, true>(L + RING_OFF, gm, S, E, TIDN, pr_acc, PRE(24));
                PEND(8);
                SEAML(pid + 0);
            }
            nA = hid; nB = wl + W_DN / 2; nK = FF; ngain = g + 3 * D;
        }
        if (IN(pid + 4)) {
            const int last = (hl == 2 * DEPTH - 1) ? 1 : 0;
            if (hl & 1) PSTART(9); else PSTART(7);
            unsigned* xchp = (unsigned*)(ws + ((hl & 1) ? WS_XCH2 : WS_XCH));
            { pg8::Gemm gm{nA, nB, M, D, nK}; pg8::StaticOrder S; S.init(M, D, G, vc, hl & 1);
              pg8::EpiPost E{xb, args.out, ngain, ssq, (unsigned long long*)(ws + WS_XG), (unsigned)(hl + 1), xmode, (unsigned*)(ctl + CW_TMO), L + LDSCTL_OFF + 1024, last};
              pg8::gemm_phase<pg8::EpiPost, pg8::StaticOrder, true, true>(L + RING_OFF, gm, S, E, TIDN, pr_acc, PRE(22)); }
            if (hl & 1) PEND(9); else PEND(7);
            SEAML(pid + 4);
        }
    }
    if (PROBE_CLASS >= 30 && PROBE_CLASS <= 33) pr_acc += ((volatile LAS unsigned*)(L + LDSCTL_OFF + 1024 + 12288))[8 + (PROBE_CLASS - 30)];
    if (PROBE_CLASS >= 0 && blockIdx.x == 0 && TIDN == 0) { const unsigned long long t0 = wall_clock64(); while (wall_clock64() - t0 < (unsigned long long)PROBE_GAIN * pr_acc) __builtin_amdgcn_s_sleep(10); }
#undef IN
#undef SEAM
}

extern "C" void kernel_launch(void* const* d_in, const int* in_sizes, int n_in, void* d_out, int out_size, void* d_ws, size_t ws_size, hipStream_t stream) {
    static int grid = 0;
    if (grid == 0) {
        if (n_in != 11 || in_sizes[0] != M * D || out_size != M * D || ws_size < WS_END) { fprintf(stderr, "kernel_launch: unexpected shapes: n_in %d in0 %d out %d ws %zu (need %zu)\n", n_in, n_in > 0 ? in_sizes[0] : -1, out_size, ws_size, (size_t)WS_END); grid = -1; return; }
        int dev = 0, cus = 0, per_cu = 0;
        if (hipGetDevice(&dev) != hipSuccess || hipDeviceGetAttribute(&cus, hipDeviceAttributeMultiprocessorCount, dev) != hipSuccess) { grid = -1; return; }
        if (hipFuncSetAttribute((const void*)mk_fwd, hipFuncAttributeMaxDynamicSharedMemorySize, LDS_BYTES) != hipSuccess) { fprintf(stderr, "kernel_launch: hipFuncSetAttribute failed\n"); grid = -1; return; }
        if (hipOccupancyMaxActiveBlocksPerMultiprocessor(&per_cu, (const void*)mk_fwd, NT, LDS_BYTES) != hipSuccess || per_cu < 1) fprintf(stderr, "kernel_launch: occupancy query reports %d\n", per_cu);
        (void)hipGetLastError();
        grid = cus;
        if (grid != 256) { fprintf(stderr, "kernel_launch: %d CUs; the fused post-norm epilogue needs exactly 256 workgroups; nothing launched\n", grid); grid = -1; return; }
    }
    if (grid < 0) return;
    if (hipMemsetAsync((char*)d_ws + WS_CTL, 0, CTL_ZERO_BYTES, stream) != hipSuccess) return;
    Args a{};
    for (int i = 0; i < 11; ++i) a.in[i] = (const float*)d_in[i];
    a.out = (float*)d_out; a.ws = (unsigned char*)d_ws; a.pad = 0;
#if MK_MULTI
    a.multi = 1;
    int ids[64]; int n = 0; ids[n++] = PH_PRO;
    for (int hl = 0; hl < 2 * DEPTH; ++hl) { const int Ly = hl >> 1, pid = 1 + hl * PH_PER_HL;
        if (!(hl & 1)) { ids[n++] = pid; ids[n++] = pid + 1; if (!(Ly & 1)) { ids[n++] = pid + 2; ids[n++] = pid + 3; } } else ids[n++] = pid;
        ids[n++] = pid + 4; }
    for (int i = 0; i < n; ++i) { a.lo = ids[i]; a.hi = ids[i] + 1; hipLaunchKernelGGL(mk_fwd, dim3(grid), dim3(NT), LDS_BYTES, stream, a); }
#else
    a.multi = 0; a.lo = 0; a.hi = PH_END;
    hipLaunchKernelGGL(mk_fwd, dim3(grid), dim3(NT), LDS_BYTES, stream, a);
#endif
    const hipError_t le = hipPeekAtLastError();
    if (le != hipSuccess) fprintf(stderr, "kernel_launch: launch failed: %s\n", hipGetErrorName(le));
}
```

```cpp
#include <hip/hip_runtime.h>
#include <cstdio>
#include <cstdint>
#include <cmath>
#ifndef MK_MULTI
#define MK_MULTI 0
#endif
#ifndef NAIVE_GATES
#define NAIVE_GATES 0
#endif
#ifndef NAIVE_B1
#define NAIVE_B1 0
#endif
#ifndef NAIVE_B2
#define NAIVE_B2 0
#endif
#ifndef NAIVE_B3
#define NAIVE_B3 0
#endif
#ifndef PROBE_CLASS
#define PROBE_CLASS (-1)
#endif
#ifndef PROBE_GAIN
#define PROBE_GAIN 8
#endif
namespace pg8 {
#define PG8_LAS __attribute__((address_space(3)))
typedef unsigned short bf16_t;
typedef short bf16x8 __attribute__((ext_vector_type(8)));
typedef float f32x4 __attribute__((ext_vector_type(4)));
typedef unsigned u32x4 __attribute__((ext_vector_type(4)));
constexpr int BM = 256, BK = 64, HALF = 128, HTB = HALF * BK * 2  , STAGE_BYTES = 8 * HTB, NXCD = 8, WGM = 8;

__host__ __device__ __forceinline__ int lds_byte(int r, int c) { const int st = (r >> 4) * 2 + (c >> 5), rr = r & 15, cc = c & 31, ob = rr * 64 + cc * 2; return st * 1024 + (ob ^ (((ob >> 9) & 1) << 5)); }
__host__ __device__ __forceinline__ void stage_rc(int b, int& R, int& C) { const int st = b / 1024, sb = b % 1024, swz = sb ^ (((sb >> 9) & 1) << 5); R = (st >> 1) * 16 + swz / 64; C = (st & 1) * 32 + (swz % 64) / 2; }
__host__ __device__ __forceinline__ int perm32(int rho) { const int n = rho >> 4, i = rho & 15; return 8 * (i >> 2) + 4 * n + (i & 3); }

struct Unit { int pm, pn; };
struct Gemm { const bf16_t* A; const bf16_t* Bt; int M, N, K; };

struct StaticOrder {
    int nM, nN, nwg, G, c, nrev;
    __host__ __device__ void init(int M, int N, int G_, int c_, int rev = 0) { nM = M / BM; nN = N / BM; nwg = nM * nN; G = G_; c = c_; nrev = (rev && nwg % G_ == 0) ? nwg / G_ : 0; }
    __host__ __device__ bool next(int i, Unit& u) const {
        const long L = (long)((nrev > 0 && i < nrev) ? (nrev - 1 - i) : i) * G + c; if (L >= nwg || (nrev > 0 && i >= nrev)) return false;
        int wgid = (int)L; { const int q = nwg / NXCD, r = nwg % NXCD, xcd = wgid % NXCD, off = wgid / NXCD; wgid = (xcd < r ? xcd * (q + 1) : r * (q + 1) + (xcd - r) * q) + off; }
        const int nig = WGM * nN, gid = wgid / nig, fm = gid * WGM, gsz = (nM - fm) < WGM ? (nM - fm) : WGM;
        u.pm = fm + ((wgid % nig) % gsz); u.pn = (wgid % nig) / gsz; return true;
    }
    __device__ __forceinline__ void a_ready(const Unit&) const {}
    __device__ __forceinline__ void done(const Unit&) const {}
};

__device__ __forceinline__ unsigned cvt_pk_bf16(float lo, float hi) { unsigned r; asm volatile("v_cvt_pk_bf16_f32 %0, %1, %2" : "=v"(r) : "v"(lo), "v"(hi)); return r; }
constexpr float RMS_EPS = 1e-6f;
constexpr unsigned SSQ_PLANE = 32768u;
__device__ __forceinline__ float rstd_row(const float* ssq, unsigned row) { const f32x4 s = *(const f32x4*)(ssq + row * 4u); return 1.0f / sqrtf(((s[0] + s[1]) + (s[2] + s[3])) * (1.0f / 1024.0f) + RMS_EPS); }
__device__ __forceinline__ u32x4 pack8(f32x4 v0, f32x4 v1) { u32x4 w; w.x = cvt_pk_bf16(v0[0], v0[1]); w.y = cvt_pk_bf16(v0[2], v0[3]); w.z = cvt_pk_bf16(v1[0], v1[1]); w.w = cvt_pk_bf16(v1[2], v1[3]); return w; }
__device__ __forceinline__ unsigned launder0() { unsigned z = 0u; asm volatile("" : "+v"(z)); return z; }
__device__ __forceinline__ u32x4 xlane4(int xlane_src, u32x4 w) { u32x4 r; r.x = (unsigned)__builtin_amdgcn_ds_bpermute(xlane_src, (int)w.x); r.y = (unsigned)__builtin_amdgcn_ds_bpermute(xlane_src, (int)w.y);
    r.z = (unsigned)__builtin_amdgcn_ds_bpermute(xlane_src, (int)w.z); r.w = (unsigned)__builtin_amdgcn_ds_bpermute(xlane_src, (int)w.w); return r; }
__device__ __forceinline__ float sigm(float x) { return __builtin_amdgcn_rcpf(1.0f + __expf(-x)); }

#define PG8_PREF_HOOKS \
    __device__ __forceinline__ f32x4 pref_load(const Unit& u, int tid) const { f32x4 v = {0.f, 0.f, 0.f, 0.f}; if (tid < 256) { const unsigned r = (unsigned)(u.pm * BM + tid); v[0] = ssq[r]; v[1] = ssq[SSQ_PLANE + r]; v[2] = ssq[2u * SSQ_PLANE + r]; v[3] = ssq[3u * SSQ_PLANE + r]; } return v; } \
    __device__ __forceinline__ void pref_store(const f32x4 v, int buf, int tid) const { if (tid < 256) tab[buf * 256 + tid] = 1.0f / sqrtf(((v[0] + v[1]) + (v[2] + v[3])) * (1.0f / 1024.0f) + RMS_EPS); }
struct EpiMlstmIn { static constexpr bool PERM = true, AFTER_DRAIN = false, PREF = true;
    bf16_t *q, *k, *v, *o; const float* ssq; PG8_LAS float* tab;
    PG8_PREF_HOOKS
    __device__ __forceinline__ void operator()(const f32x4 (&acc)[2][2][4][2], const Unit& u, int wr, int wc, int fr, int fq, int buf) const {
        const int pn = u.pn; bf16_t* base; int ldc, colt; bool sig = false;
        if (pn < 2) { base = q; ldc = 512; colt = pn * 256; } else if (pn < 4) { base = k; ldc = 512; colt = (pn - 2) * 256; }
        else if (pn < 8) { base = v; ldc = 1024; colt = (pn - 4) * 256; } else { base = o; ldc = 1024; colt = (pn - 8) * 256; sig = true; }
        const unsigned z = launder0(), ln = fq * 16 + fr + z; const int xs = (int)(((ln & 3u) * 16u + (ln >> 2)) * 4u);
        const unsigned row0 = u.pm * BM + wr * 64 + fr + z, prow0 = u.pm * BM + wr * 64 + (ln >> 2), pcol0 = colt + wc * 32 + 8 * (ln & 3u);
#pragma unroll
        for (int ai = 0; ai < 2; ++ai)
#pragma unroll
            for (int m = 0; m < 4; ++m) { const unsigned row = row0 + ai * HALF + m * 16; const float rs = tab[buf * 256 + (int)(row - u.pm * BM)], rsx = sig ? rs * -1.4426950408889634f : rs; bf16_t* rowp = base + ((prow0 + ai * HALF + m * 16) * (unsigned)ldc + pcol0);
#pragma unroll
                for (int bj = 0; bj < 2; ++bj) { f32x4 v0 = acc[ai][bj][m][0] * rsx, v1 = acc[ai][bj][m][1] * rsx;
                    if (sig) {
#pragma unroll
                        for (int j = 0; j < 4; ++j) { v0[j] = __builtin_amdgcn_exp2f(v0[j]); v1[j] = __builtin_amdgcn_exp2f(v1[j]); }
                        v0 = v0 + 1.0f; v1 = v1 + 1.0f;
#pragma unroll
                        for (int j = 0; j < 4; ++j) { v0[j] = __builtin_amdgcn_rcpf(v0[j]); v1[j] = __builtin_amdgcn_rcpf(v1[j]); } }
                    *(u32x4*)(rowp + bj * HALF) = xlane4(xs, pack8(v0, v1)); } }
    }
};
struct EpiConvIn { static constexpr bool PERM = true, AFTER_DRAIN = false, PREF = true;
    bf16_t *ub, *bg; const float* ssq; PG8_LAS float* tab;
    PG8_PREF_HOOKS
    __device__ __forceinline__ void operator()(const f32x4 (&acc)[2][2][4][2], const Unit& u, int wr, int wc, int fr, int fq, int buf) const {
        const int pn = u.pn; const unsigned z = launder0(), ln = fq * 16 + fr + z; const int xs = (int)(((ln & 3u) * 16u + (ln >> 2)) * 4u);
        const unsigned row0 = u.pm * BM + wr * 64 + fr + z, prow0 = u.pm * BM + wr * 64 + (ln >> 2);
        if (pn < 8) { const unsigned pcol0 = pn * 128 + wc * 32 + 8 * (ln & 3u);
#pragma unroll
            for (int ai = 0; ai < 2; ++ai)
#pragma unroll
                for (int m = 0; m < 4; ++m) { const unsigned row = row0 + ai * HALF + m * 16; const float rs = tab[buf * 256 + (int)(row - u.pm * BM)], rs2 = rs * rs;
                    const f32x4 v0 = acc[ai][0][m][0] * acc[ai][1][m][0] * rs2, v1 = acc[ai][0][m][1] * acc[ai][1][m][1] * rs2;
                    *(u32x4*)(ub + ((prow0 + ai * HALF + m * 16) * 1024u + pcol0)) = xlane4(xs, pack8(v0, v1)); }
        } else { const unsigned pcol0 = (pn - 8) * 256 + wc * 32 + 8 * (ln & 3u);
#pragma unroll
            for (int ai = 0; ai < 2; ++ai)
#pragma unroll
                for (int m = 0; m < 4; ++m) { const unsigned row = row0 + ai * HALF + m * 16; const float rs = tab[buf * 256 + (int)(row - u.pm * BM)]; bf16_t* rowp = bg + ((prow0 + ai * HALF + m * 16) * 1024u + pcol0);
#pragma unroll
                    for (int bj = 0; bj < 2; ++bj) *(u32x4*)(rowp + bj * HALF) = xlane4(xs, pack8(acc[ai][bj][m][0] * rs, acc[ai][bj][m][1] * rs)); }
        }
    }
};
__device__ __forceinline__ float relu1(float x) { float r; asm("v_max_f32 %0, 0, %1" : "=v"(r) : "v"(x)); return r; }
struct EpiUp { static constexpr bool PERM = true, AFTER_DRAIN = false, PREF = true;
    bf16_t* hid; const float* ssq; PG8_LAS float* tab;
    PG8_PREF_HOOKS
    __device__ __forceinline__ void operator()(const f32x4 (&acc)[2][2][4][2], const Unit& u, int wr, int wc, int fr, int fq, int buf) const {
        const unsigned z = launder0(), ln = fq * 16 + fr + z; const int xs = (int)(((ln & 3u) * 16u + (ln >> 2)) * 4u);
        const unsigned row0 = u.pm * BM + wr * 64 + fr + z, prow0 = u.pm * BM + wr * 64 + (ln >> 2), pcol0 = u.pn * BM + wc * 32 + 8 * (ln & 3u);
#pragma unroll
        for (int ai = 0; ai < 2; ++ai)
#pragma unroll
            for (int m = 0; m < 4; ++m) { const unsigned row = row0 + ai * HALF + m * 16; const float rs = tab[buf * 256 + (int)(row - u.pm * BM)], rs2 = rs * rs; bf16_t* rowp = hid + ((prow0 + ai * HALF + m * 16) * 4096u + pcol0);
#pragma unroll
                for (int bj = 0; bj < 2; ++bj) { const f32x4 x0 = acc[ai][bj][m][0], x1 = acc[ai][bj][m][1]; f32x4 t0, t1;
#pragma unroll
                    for (int j = 0; j < 4; ++j) { t0[j] = relu1(x0[j]); t1[j] = relu1(x1[j]); }
                    const f32x4 v0 = (x0 * t0) * rs2, v1 = (x1 * t1) * rs2;
                    *(u32x4*)(rowp + bj * HALF) = xlane4(xs, pack8(v0, v1)); } }
    }
};
struct EpiF32P { static constexpr bool PERM = true, AFTER_DRAIN = false, PREF = false;
    float* C; int ldc;
    __device__ __forceinline__ void operator()(const f32x4 (&acc)[2][2][4][2], const Unit& u, int wr, int wc, int fr, int fq) const {
        const unsigned row0 = u.pm * BM + wr * 64 + fr + launder0(), col0 = u.pn * BM + wc * 32 + 8 * fq;
#pragma unroll
        for (int ai = 0; ai < 2; ++ai)
#pragma unroll
            for (int m = 0; m < 4; ++m) { float* rowp = C + ((row0 + ai * HALF + m * 16) * (unsigned)ldc + col0);
#pragma unroll
                for (int bj = 0; bj < 2; ++bj) { *(f32x4*)(rowp + bj * HALF) = acc[ai][bj][m][0]; *(f32x4*)(rowp + bj * HALF + 4) = acc[ai][bj][m][1]; } }
    }
};
struct EpiPost { static constexpr bool PERM = true, AFTER_DRAIN = false, PREF = false;
    bf16_t* xb; float* out; const float* gain; float* ssq; unsigned long long* xg; unsigned tag; int xm; unsigned* tmo; PG8_LAS unsigned char* lds; int last;
    __device__ __forceinline__ void operator()(const f32x4 (&acc)[2][2][4][2], const Unit& u, int wr, int wc, int fr_in, int fq_in) const {
        const int rowbase = (int)launder0(), fr = fr_in + rowbase, fq = fq_in + rowbase;
        const int wid = wr * 4 + wc, lane = fq * 16 + fr;
        PG8_LAS float* P = (PG8_LAS float*)lds;
        PG8_LAS float* S = (PG8_LAS float*)(lds + 4096);
        PG8_LAS float* P2 = (PG8_LAS float*)(lds + 8192);
        const unsigned col0 = u.pn * BM + wc * 32 + 8 * fq;
        const unsigned lnp = (unsigned)lane; const int xs = (int)(((lnp & 3u) * 16u + (lnp >> 2)) * 4u), xr = (int)((unsigned)(fr * 4 + fq) * 4u);
        const unsigned pbase = (unsigned)(rowbase + u.pm * BM + wr * 64 + (int)(lnp >> 2)) * 1024u + u.pn * BM + wc * 32 + 8 * (lnp & 3u);
        u32x4 xw[2][4][2];
#pragma unroll
        for (int ai = 0; ai < 2; ++ai)
#pragma unroll
            for (int m = 0; m < 4; ++m) { const unsigned off = pbase + (unsigned)(ai * HALF + m * 16) * 1024u;
                xw[ai][m][0] = *(const u32x4*)(xb + off); xw[ai][m][1] = *(const u32x4*)(xb + off + HALF); }
        float sp[8];
#pragma unroll
        for (int ai = 0; ai < 2; ++ai)
#pragma unroll
            for (int m = 0; m < 4; ++m) { float sv = 0.f;
#pragma unroll
                for (int bj = 0; bj < 2; ++bj)
#pragma unroll
                    for (int n = 0; n < 2; ++n) { const f32x4 x = acc[ai][bj][m][n]; sv += (x[0] * x[0] + x[1] * x[1]) + (x[2] * x[2] + x[3] * x[3]); }
                sp[ai * 4 + m] = sv; }
#pragma unroll
        for (int i = 0; i < 8; ++i) sp[i] += __shfl_xor(sp[i], 16);
#pragma unroll
        for (int i = 0; i < 8; ++i) sp[i] += __shfl_xor(sp[i], 32);
        if (fq == 0) {
#pragma unroll
            for (int i = 0; i < 8; ++i) P[((i >> 2) * HALF + wr * 64 + (i & 3) * 16 + fr) * 4 + wc] = sp[i]; }
        asm volatile("s_waitcnt lgkmcnt(0)" ::: "memory"); __builtin_amdgcn_s_barrier(); asm volatile("" ::: "memory");
        const int row = wid * 32 + (lane & 31); const unsigned grow = (unsigned)(rowbase + u.pm * BM + row);
        if (lane < 32) { const f32x4 a = *(const PG8_LAS f32x4*)(P + row * 4); const float t = (a[0] + a[1]) + (a[2] + a[3]);
            const unsigned long long g = ((unsigned long long)tag << 32) | (unsigned long long)__float_as_uint(t); unsigned long long* gp = xg + (size_t)u.pn * SSQ_PLANE + grow;
            if (xm) __hip_atomic_store(gp, g, __ATOMIC_RELAXED, __HIP_MEMORY_SCOPE_WORKGROUP); else __hip_atomic_store(gp, g, __ATOMIC_RELAXED, __HIP_MEMORY_SCOPE_AGENT); }
        { const unsigned long long* gq = xg + (size_t)(2 * (lane >> 5)) * SSQ_PLANE + grow; float tsum; bool ok; unsigned spins = 0u;
            for (;;) {
                const unsigned long long ga = __hip_atomic_load(gq, __ATOMIC_RELAXED, __HIP_MEMORY_SCOPE_AGENT), gb = __hip_atomic_load(gq + SSQ_PLANE, __ATOMIC_RELAXED, __HIP_MEMORY_SCOPE_AGENT);
                ok = ((unsigned)(ga >> 32) == tag) && ((unsigned)(gb >> 32) == tag); tsum = __uint_as_float((unsigned)ga) + __uint_as_float((unsigned)gb);
                if (__builtin_amdgcn_ballot_w64(ok) == ~0ull) break;
                if (++spins > (1u << 20)) { if (lane == 0) __hip_atomic_store(tmo, 1u, __ATOMIC_RELAXED, __HIP_MEMORY_SCOPE_AGENT); break; }
                __builtin_amdgcn_s_sleep(1); }
            tsum += __shfl_xor(tsum, 32); const bool ok2 = ok && (bool)__shfl_xor((int)ok, 32);
            if (lane < 32) S[row] = ok2 ? 1.0f / sqrtf(tsum * (1.0f / 1024.0f) + RMS_EPS) : __builtin_nanf(""); }
        asm volatile("s_waitcnt lgkmcnt(0)" ::: "memory"); __builtin_amdgcn_s_barrier(); asm volatile("" ::: "memory");
        f32x4 gv[2][2];
#pragma unroll
        for (int bj = 0; bj < 2; ++bj) { gv[bj][0] = *(const f32x4*)(gain + col0 + bj * HALF); gv[bj][1] = *(const f32x4*)(gain + col0 + bj * HALF + 4); }
        float s2v[8];
#pragma unroll
        for (int ai = 0; ai < 2; ++ai)
#pragma unroll
            for (int m = 0; m < 4; ++m) { const int rl = ai * HALF + wr * 64 + m * 16 + fr; const float c = S[rl]; const unsigned off = (unsigned)(rowbase + u.pm * BM + rl) * 1024u + col0; float s2 = 0.f;
#pragma unroll
                for (int bj = 0; bj < 2; ++bj) { const u32x4 xv = xlane4(xr, xw[ai][m][bj]);
                    f32x4 x0, x1; x0[0] = __uint_as_float(xv.x << 16); x0[1] = __uint_as_float(xv.x & 0xffff0000u); x0[2] = __uint_as_float(xv.y << 16); x0[3] = __uint_as_float(xv.y & 0xffff0000u);
                    x1[0] = __uint_as_float(xv.z << 16); x1[1] = __uint_as_float(xv.z & 0xffff0000u); x1[2] = __uint_as_float(xv.w << 16); x1[3] = __uint_as_float(xv.w & 0xffff0000u);
                    x0 = x0 + acc[ai][bj][m][0] * gv[bj][0] * c; x1 = x1 + acc[ai][bj][m][1] * gv[bj][1] * c;
                    if (last) { *(f32x4*)(out + off + bj * HALF) = x0; *(f32x4*)(out + off + bj * HALF + 4) = x1; }
                    else { const u32x4 w = pack8(x0, x1); *(u32x4*)(xb + pbase + (unsigned)(ai * HALF + m * 16) * 1024u + bj * HALF) = xlane4(xs, w);
                        const float r0 = __uint_as_float(w.x << 16), r1 = __uint_as_float(w.x & 0xffff0000u), r2 = __uint_as_float(w.y << 16), r3 = __uint_as_float(w.y & 0xffff0000u);
                        const float r4 = __uint_as_float(w.z << 16), r5 = __uint_as_float(w.z & 0xffff0000u), r6 = __uint_as_float(w.w << 16), r7 = __uint_as_float(w.w & 0xffff0000u);
                        s2 += ((r0 * r0 + r1 * r1) + (r2 * r2 + r3 * r3)) + ((r4 * r4 + r5 * r5) + (r6 * r6 + r7 * r7)); } }
                s2v[ai * 4 + m] = s2; }
#pragma unroll
        for (int i = 0; i < 8; ++i) s2v[i] += __shfl_xor(s2v[i], 16);
#pragma unroll
        for (int i = 0; i < 8; ++i) s2v[i] += __shfl_xor(s2v[i], 32);
        if (fq == 0) {
#pragma unroll
            for (int i = 0; i < 8; ++i) P2[((i >> 2) * HALF + wr * 64 + (i & 3) * 16 + fr) * 4 + wc] = s2v[i]; }
        asm volatile("s_waitcnt lgkmcnt(0)" ::: "memory"); __builtin_amdgcn_s_barrier(); asm volatile("" ::: "memory");
        if (lane < 32) { const f32x4 a = *(const PG8_LAS f32x4*)(P2 + row * 4); ssq[(unsigned)u.pn * SSQ_PLANE + grow] = (a[0] + a[1]) + (a[2] + a[3]); }
    }
};
template <class Epi, class Sched, bool ALIGN_EPI = false, bool SP2 = false>
__device__ __forceinline__ void gemm_phase(PG8_LAS unsigned char* lds, const Gemm g, const Sched& S, const Epi& E, const int tid_in, unsigned long long& pr_k, unsigned long long& pr_e) {
    const int tid = tid_in, wid = __builtin_amdgcn_readfirstlane(tid >> 6), lane = tid & 63, wr = wid >> 2, wc = wid & 3, fr = lane & 15, fq = lane >> 4;
    const int K = g.K, nt = K / BK;
    unsigned voffA[2], voffB[2];
#pragma unroll
    for (int i = 0; i < 2; ++i) { int R, C; stage_rc(tid * 16 + i * 8192, R, C); const int Rb = Epi::PERM ? ((R & ~31) + perm32(R & 31)) : R;
        voffA[i] = (unsigned)(R * K + C) * 2u; voffB[i] = (unsigned)(Rb * K + C) * 2u; }
    const size_t kstep = (size_t)(BK * 2);
    const size_t hstep = (size_t)HALF * K * 2;
    const size_t tstep = 2 * hstep;
    const unsigned ldsw = (unsigned)wid * 1024u;
    const int aoff = lds_byte(wr * 64 + fr, fq * 8), boff = lds_byte(wc * 32 + fr, fq * 8);
#define PG8_SA(b, h) (((b) * 2 + (h)) * HTB)
#define PG8_SB(b, h) ((4 + (b) * 2 + (h)) * HTB)
#define PG8_STAGE(bufoff, gbase, voff) do { _Pragma("unroll") for (int _i = 0; _i < 2; ++_i) \
        __builtin_amdgcn_global_load_lds((const unsigned*)((const char*)(gbase) + (voff)[_i]), (PG8_LAS unsigned*)(lds + (bufoff) + ldsw + _i * 8192), 16, 0, 0); } while (0)
#define PG8_LDA(dst, b, h) do { _Pragma("unroll") for (int m = 0; m < 4; ++m) _Pragma("unroll") for (int k = 0; k < 2; ++k) dst[m][k] = *(const PG8_LAS bf16x8*)(lds + PG8_SA(b, h) + aoff + m * 2048 + k * 1024); } while (0)
#define PG8_LDB(dst, b, h) do { _Pragma("unroll") for (int n = 0; n < 2; ++n) _Pragma("unroll") for (int k = 0; k < 2; ++k) dst[n][k] = *(const PG8_LAS bf16x8*)(lds + PG8_SB(b, h) + boff + n * 2048 + k * 1024); } while (0)
#define PG8_MMA(ai, bj, At, Bt) do { __builtin_amdgcn_s_setprio(1); _Pragma("unroll") for (int m = 0; m < 4; ++m) _Pragma("unroll") for (int n = 0; n < 2; ++n) _Pragma("unroll") for (int k = 0; k < 2; ++k) \
        acc[ai][bj][m][n] = __builtin_amdgcn_mfma_f32_16x16x32_bf16(Bt[n][k], At[m][k], acc[ai][bj][m][n], 0, 0, 0); __builtin_amdgcn_s_setprio(0); } while (0)
#define PG8_WAIT_V(n) asm volatile("s_waitcnt vmcnt(" #n ")" ::: "memory")
#define PG8_WAIT_L(n) asm volatile("s_waitcnt lgkmcnt(" #n ")" ::: "memory")
#define PG8_BAR __builtin_amdgcn_s_barrier()
#define PG8_SCHED __builtin_amdgcn_sched_barrier(0)
    Unit cur, nxt; int ui = 0;
    if (!S.next(0, cur)) return;
    f32x4 acc[2][2][4][2];
#pragma unroll
    for (int a = 0; a < 2; ++a)
#pragma unroll
        for (int b = 0; b < 2; ++b)
#pragma unroll
            for (int m = 0; m < 4; ++m)
#pragma unroll
                for (int n = 0; n < 2; ++n) acc[a][b][m][n] = (f32x4){0.f, 0.f, 0.f, 0.f};
    bf16x8 At[4][2], B0[2][2], B1[2][2];
    const char* cA = (const char*)g.A + (size_t)cur.pm * tstep; const char* cB = (const char*)g.Bt + (size_t)cur.pn * tstep;
    S.a_ready(cur);
    if constexpr (Epi::PREF) { const f32x4 pv0 = E.pref_load(cur, tid); E.pref_store(pv0, 0, tid); }
    if constexpr (SP2) {
        PG8_STAGE(PG8_SB(0, 0), cB, voffB); PG8_STAGE(PG8_SB(0, 1), cB + hstep, voffB); PG8_STAGE(PG8_SA(0, 0), cA, voffA); PG8_STAGE(PG8_SA(0, 1), cA + hstep, voffA);
        if (wr == 1) PG8_BAR;
        PG8_WAIT_V(2); PG8_BAR;
        PG8_STAGE(PG8_SB(1, 0), cB + kstep, voffB); PG8_STAGE(PG8_SA(1, 0), cA + kstep, voffA); PG8_STAGE(PG8_SB(1, 1), cB + hstep + kstep, voffB);
        PG8_WAIT_V(6); PG8_BAR;
    } else {
        PG8_STAGE(PG8_SB(0, 0), cB, voffB); PG8_STAGE(PG8_SA(0, 0), cA, voffA); PG8_STAGE(PG8_SB(0, 1), cB + hstep, voffB); PG8_STAGE(PG8_SA(0, 1), cA + hstep, voffA);
        if (wr == 1) PG8_BAR;
        PG8_WAIT_V(4); PG8_BAR;
        PG8_STAGE(PG8_SB(1, 0), cB + kstep, voffB); PG8_STAGE(PG8_SA(1, 0), cA + kstep, voffA); PG8_STAGE(PG8_SB(1, 1), cB + hstep + kstep, voffB);
        PG8_WAIT_V(6); PG8_BAR;
    }
    for (;;) {
        const bool has_next = S.next(ui + 1, nxt);
        const char* nA = has_next ? (const char*)g.A + (size_t)nxt.pm * tstep : cA + (size_t)(nt - 2) * kstep; const char* nB = has_next ? (const char*)g.Bt + (size_t)nxt.pn * tstep : cB + (size_t)(nt - 2) * kstep;
        unsigned long long pt0 = 0ull; if (PROBE_CLASS == 20) pt0 = wall_clock64(); if (PROBE_CLASS == 50) pt0 = (unsigned long long)clock64();
        for (int t = 0; t < nt; t += 2) {
            const bool last = (t == nt - 2);
            const char* a1 = cA + (size_t)(t + 1) * kstep;
            const char* a2 = last ? nA : cA + (size_t)(t + 2) * kstep; const char* b2 = last ? nB : cB + (size_t)(t + 2) * kstep;
            const char* a3 = a2 + kstep; const char* b3 = b2 + kstep;
            if (last && has_next) S.a_ready(nxt);
            if constexpr (SP2) {
            PG8_LDB(B0, 0, 0); PG8_LDB(B1, 0, 1); PG8_SCHED; PG8_LDA(At, 0, 0); PG8_STAGE(PG8_SA(1, 1), a1 + hstep, voffA);
            PG8_WAIT_V(8); PG8_WAIT_L(0); PG8_BAR; PG8_MMA(0, 0, At, B0); PG8_MMA(0, 1, At, B1); PG8_BAR; PG8_SCHED;
            PG8_LDA(At, 0, 1); PG8_STAGE(PG8_SB(0, 0), b2, voffB); PG8_STAGE(PG8_SB(0, 1), b2 + hstep, voffB); PG8_STAGE(PG8_SA(0, 0), a2, voffA);
            PG8_WAIT_V(8); PG8_WAIT_L(0); PG8_BAR; PG8_MMA(1, 0, At, B0); PG8_MMA(1, 1, At, B1); PG8_BAR; PG8_SCHED;
            PG8_LDB(B0, 1, 0); PG8_LDB(B1, 1, 1); PG8_SCHED; PG8_LDA(At, 1, 0); PG8_STAGE(PG8_SA(0, 1), a2 + hstep, voffA);
            PG8_WAIT_V(8); PG8_WAIT_L(0); PG8_BAR; PG8_MMA(0, 0, At, B0); PG8_MMA(0, 1, At, B1); PG8_BAR; PG8_SCHED;
            PG8_LDA(At, 1, 1); PG8_STAGE(PG8_SB(1, 0), b3, voffB); PG8_STAGE(PG8_SB(1, 1), b3 + hstep, voffB); PG8_STAGE(PG8_SA(1, 0), a3, voffA);
            PG8_WAIT_V(8); PG8_WAIT_L(0); PG8_BAR; PG8_MMA(1, 0, At, B0); PG8_MMA(1, 1, At, B1); PG8_BAR; PG8_SCHED;
            } else {
            PG8_LDB(B0, 0, 0); PG8_SCHED; PG8_LDA(At, 0, 0); PG8_STAGE(PG8_SA(1, 1), a1 + hstep, voffA);
            PG8_WAIT_L(8); PG8_BAR; PG8_WAIT_L(0); PG8_MMA(0, 0, At, B0); PG8_BAR; PG8_SCHED;
            PG8_LDB(B1, 0, 1); PG8_STAGE(PG8_SB(0, 0), b2, voffB);
            PG8_BAR; PG8_WAIT_L(0); PG8_MMA(0, 1, At, B1); PG8_BAR;
            PG8_LDA(At, 0, 1); PG8_STAGE(PG8_SA(0, 0), a2, voffA);
            PG8_BAR; PG8_WAIT_L(0); PG8_MMA(1, 0, At, B0); PG8_BAR; PG8_SCHED;
            PG8_STAGE(PG8_SB(0, 1), b2 + hstep, voffB);
            PG8_WAIT_V(6); PG8_BAR; PG8_MMA(1, 1, At, B1); PG8_BAR;
            PG8_LDB(B0, 1, 0); PG8_SCHED; PG8_LDA(At, 1, 0); PG8_STAGE(PG8_SA(0, 1), a2 + hstep, voffA);
            PG8_WAIT_L(8); PG8_BAR; PG8_WAIT_L(0); PG8_MMA(0, 0, At, B0); PG8_BAR; PG8_SCHED;
            PG8_LDB(B1, 1, 1); PG8_STAGE(PG8_SB(1, 0), b3, voffB);
            PG8_BAR; PG8_WAIT_L(0); PG8_MMA(0, 1, At, B1); PG8_BAR;
            PG8_LDA(At, 1, 1); PG8_STAGE(PG8_SA(1, 0), a3, voffA);
            PG8_BAR; PG8_WAIT_L(0); PG8_MMA(1, 0, At, B0); PG8_BAR; PG8_SCHED;
            PG8_STAGE(PG8_SB(1, 1), b3 + hstep, voffB);
            PG8_WAIT_V(6); PG8_BAR; PG8_MMA(1, 1, At, B1); PG8_BAR;
            }
        }
        if (PROBE_CLASS == 20) pr_k += wall_clock64() - pt0;
        if (PROBE_CLASS == 50) pr_k += ((unsigned long long)clock64() - pt0) >> 8;
        if (PROBE_CLASS >= 21) pt0 = wall_clock64();
        if constexpr (ALIGN_EPI) { if (wr == 0) PG8_BAR; }
        if constexpr (!Epi::AFTER_DRAIN) {
            if constexpr (Epi::PREF) { f32x4 pvn = {0.f, 0.f, 0.f, 0.f}; if (has_next) pvn = E.pref_load(nxt, tid); E(acc, cur, wr, wc, fr, fq, ui & 1); if (has_next) E.pref_store(pvn, (ui + 1) & 1, tid); }
            else E(acc, cur, wr, wc, fr, fq);
            S.done(cur); }
        if (PROBE_CLASS >= 21) pr_e += wall_clock64() - pt0;
        if (!has_next) break;
#pragma unroll
        for (int a = 0; a < 2; ++a)
#pragma unroll
            for (int b = 0; b < 2; ++b)
#pragma unroll
                for (int m = 0; m < 4; ++m)
#pragma unroll
                    for (int n = 0; n < 2; ++n) acc[a][b][m][n] = (f32x4){0.f, 0.f, 0.f, 0.f};
        cur = nxt; cA = nA; cB = nB; ++ui;
        if constexpr (ALIGN_EPI) { if (wr == 1) PG8_BAR; }
    }
    unsigned long long pt1 = 0ull; if (PROBE_CLASS >= 21) pt1 = wall_clock64();
    PG8_WAIT_V(0);
    if constexpr (!ALIGN_EPI) { if (wr == 0) PG8_BAR; }
    PG8_BAR;
    if constexpr (Epi::AFTER_DRAIN) { E.fused(acc, cur, wr, wc, fr, fq, lds, wid, lane); S.done(cur); }
    if (PROBE_CLASS >= 21) pr_e += wall_clock64() - pt1;
#undef PG8_SA
#undef PG8_SB
#undef PG8_STAGE
#undef PG8_LDA
#undef PG8_LDB
#undef PG8_MMA
#undef PG8_WAIT_V
#undef PG8_WAIT_L
#undef PG8_BAR
#undef PG8_SCHED
}
}
#define GAS __attribute__((address_space(1)))
#define LAS __attribute__((address_space(3)))
typedef unsigned short bf16;
typedef unsigned v4u __attribute__((ext_vector_type(4)));
typedef float f32x4 __attribute__((ext_vector_type(4)));
typedef short bf16x8 __attribute__((ext_vector_type(8)));
typedef GAS unsigned gu32;
typedef GAS unsigned long long gu64;
#define RLX_AGENT __ATOMIC_RELAXED, __HIP_MEMORY_SCOPE_AGENT
#define LDS_WAIT() asm volatile("s_waitcnt lgkmcnt(0)" ::: "memory")
#define VM_WAIT() asm volatile("s_waitcnt vmcnt(0)" ::: "memory")
__device__ __forceinline__ unsigned long long rt() { return __builtin_amdgcn_s_memrealtime(); }
__device__ __forceinline__ unsigned f2bf(float f) { unsigned u = __builtin_bit_cast(unsigned, f); return (u + 0x7fffu + ((u >> 16) & 1u)) >> 16; }
__device__ __forceinline__ unsigned pk2(float lo, float hi) { return f2bf(lo) | (f2bf(hi) << 16); }

#define XB_TMO      128
#define XB_XCNT(j)  (256  + 64 * (j))
#define XB_XSUB(j)  (1280 + 64 * (j))
#define XB_XGEN(j)  (2304 + 64 * (j))
#define XB_TOP      3328
#define XB_TOPGEN   3392
#define XCD_BAR_WORDS 3456
#define XB_SPIN_CAP (1u << 18)

__device__ __forceinline__ unsigned xb_ld(unsigned* p)              { return __hip_atomic_load(p, __ATOMIC_RELAXED, __HIP_MEMORY_SCOPE_AGENT); }
__device__ __forceinline__ unsigned xb_add(unsigned* p, unsigned v) { return __hip_atomic_fetch_add(p, v, __ATOMIC_RELAXED, __HIP_MEMORY_SCOPE_AGENT); }
__device__ __forceinline__ unsigned xb_xcc_id() { return (unsigned)__builtin_amdgcn_s_getreg((3 << 11) | 20) & 0xFu; }
#define XB_SPIN(cond, bar) do { unsigned _sp = 0; while (cond) { __builtin_amdgcn_s_sleep(1); \
    if ((++_sp & 255u) == 0u) { if (xb_ld(&(bar)[XB_TMO])) break; if (_sp > XB_SPIN_CAP) { atomicAdd(&(bar)[XB_TMO], 1u); break; } } } } while (0)

__device__ __forceinline__ unsigned xb_lane_now() { unsigned z; asm volatile("v_mov_b32 %0, 0" : "=v"(z)); return __builtin_amdgcn_mbcnt_hi(~0u, __builtin_amdgcn_mbcnt_lo(~0u, z)); }
#define XB_T0(b) ((b).wv == 0u && xb_lane_now() == 0u)
struct XcdBarrier {
    unsigned wv;
    unsigned* bar; unsigned x;
    volatile LAS unsigned* st;
};

__device__ __forceinline__ XcdBarrier xcd_barrier_post(unsigned* bar, volatile LAS unsigned* st) {
    XcdBarrier b; b.bar = bar; b.x = xb_xcc_id(); b.st = st;
    if (threadIdx.x == 0) (void)xb_add(&bar[XB_XCNT(b.x)], 1u);
    return b;
}
__device__ __forceinline__ void xcd_barrier_complete(unsigned* bar, unsigned x, unsigned& nloc, unsigned& nx) {
    const unsigned G = gridDim.x * gridDim.y * gridDim.z;
    unsigned sum, cnt, mine, sp = 0u;
    for (;;) {
        sum = 0u; cnt = 0u; mine = 0u;
#pragma unroll
        for (unsigned j = 0; j < 16; ++j) { const unsigned c = xb_ld(&bar[XB_XCNT(j)]); sum += c; cnt += (c > 0u) ? 1u : 0u; mine = (j == x) ? c : mine; }
        if (sum == G) break;
        __builtin_amdgcn_s_sleep(1);
        if ((++sp & 255u) == 0u) { if (xb_ld(&bar[XB_TMO])) break; if (sp > XB_SPIN_CAP) { atomicAdd(&bar[XB_TMO], 1u); break; } }
    }
    nloc = mine > 0u ? mine : 1u; nx = cnt > 0u ? cnt : 1u;
}

__device__ __forceinline__ void xcd_barrier(const XcdBarrier& b) {
    asm volatile("s_waitcnt vmcnt(0)" ::: "memory");
    __syncthreads();
    if (XB_T0(b)) {
        unsigned* bar = b.bar;
        __builtin_amdgcn_s_waitcnt(0);
        unsigned nloc = b.st[0], nx = b.st[1];
        if (nloc == 0u) { xcd_barrier_complete(bar, b.x, nloc, nx); b.st[0] = nloc; b.st[1] = nx; }
        const unsigned old = xb_add(&bar[XB_XSUB(b.x)], 1u);
        const unsigned gen = old / nloc;
        if (old + 1u == (gen + 1u) * nloc) {
            __builtin_amdgcn_fence(__ATOMIC_RELEASE, "agent");
            asm volatile("s_waitcnt vmcnt(0)" ::: "memory");
            const unsigned og = xb_add(&bar[XB_TOP], 1u);
            const unsigned tg = og / nx;
            if (og + 1u == (tg + 1u) * nx) xb_add(&bar[XB_TOPGEN], 1u);
            else XB_SPIN(xb_ld(&bar[XB_TOPGEN]) == tg, bar);
            __builtin_amdgcn_fence(__ATOMIC_ACQUIRE, "agent");
            xb_add(&bar[XB_XGEN(b.x)], 1u);
            asm volatile("s_waitcnt vmcnt(0)" ::: "memory");
        } else {
            XB_SPIN(xb_ld(&bar[XB_XGEN(b.x)]) == gen, bar);
            __builtin_amdgcn_fence(__ATOMIC_ACQUIRE, "agent");
            asm volatile("s_waitcnt vmcnt(0)" ::: "memory");
        }
    }
    __syncthreads();
}
constexpr int NWAVES = 8, NT = 512;
constexpr int BATCH = 4, SEQ = 8192, D = 1024, FF = 4096, M = BATCH * SEQ, DEPTH = 4;
constexpr int NH = 4, DK = 128, DV = 256, CH = 128, NCH = SEQ / CH, NUNIT = BATCH * NH * NCH;
constexpr int MIN_COLS = 3080;
constexpr float EPS = 1e-6f, GATE_CAP = 15.0f;
constexpr size_t MiB = 1u << 20;
constexpr size_t WS_CTL = 0, CTL_ZERO_BYTES = 1 * MiB;
constexpr size_t WS_SSQ = 1 * MiB;
constexpr size_t WS_XCH = 1 * MiB + 512 * 1024;
constexpr size_t WS_IG = 2 * MiB, WS_LF = 2 * MiB + 512 * 1024;
constexpr size_t WS_BLAST = 3 * MiB, WS_MLOC = 3 * MiB + 128 * 1024, WS_MPREV = 3 * MiB + 256 * 1024;
constexpr size_t WS_NLOC = 3 * MiB + 512 * 1024, WS_NPREV = 4 * MiB;
constexpr size_t WS_WGT = 4 * MiB + 512 * 1024;
constexpr size_t WS_XCH2 = 5 * MiB;
constexpr size_t WS_XG = 6 * MiB;
constexpr size_t WS_W = 8 * MiB, W_LAYER = 24 * MiB, W_IN = 0, W_OUT = 6 * MiB, W_UP = 8 * MiB, W_DN = 16 * MiB;
constexpr size_t WS_XB = 104 * MiB;
constexpr size_t WS_S = 168 * MiB;
constexpr size_t WS_HID = WS_S;
constexpr size_t WS_Q = WS_S, WS_K = WS_S + 32 * MiB, WS_V = WS_S + 64 * MiB, WS_O = WS_S + 128 * MiB;
constexpr size_t WS_KVT = WS_S + 192 * MiB, WS_CT = WS_S + 256 * MiB;
constexpr size_t WS_BG = WS_S, WS_U = WS_S + 64 * MiB;
constexpr size_t WS_END = WS_S + 320 * MiB;
constexpr int CW_TMO = 0, CW_CODE = 1, CW_BAR = 4096, CW_SEAM = 16384;
constexpr int RING_OFF = 0, RING_BYTES = 131072, LDSCTL_OFF = RING_BYTES, MISC_OFF = LDSCTL_OFF + 320, LDS_BYTES = 147456;
constexpr int PH_PRO = 0, PH_PER_HL = 6, PH_END = 1 + 7 * PH_PER_HL + 5;

__device__ __forceinline__ int launder_i(int v) { asm volatile("" : "+v"(v)); return v; }
__device__ __forceinline__ float bf2f(bf16 b) { return __uint_as_float(((unsigned)b) << 16); }
__device__ __forceinline__ float wave_sum(float v) {
#pragma unroll
    for (int o = 1; o < 64; o <<= 1) v += __shfl_xor(v, o);
    return v;
}
struct P0Item { const float* W; const float* gain; bf16* WT; int ldw, src_col0, k0, K, dst_row0; float cscale; };
__device__ __forceinline__ void p0_load(const P0Item& I, float (&v)[32], int lane) {
#pragma unroll
    for (int i = 0; i < 32; ++i) { const int kk = 2 * i + (lane >> 5); v[i] = I.W[(size_t)(I.k0 + kk) * I.ldw + I.src_col0 + (lane & 31)]; }
}
__device__ __forceinline__ void p0_finish(const P0Item& I, const float (&v)[32], LAS float* scr, int lane) {
#pragma unroll
    for (int i = 0; i < 32; ++i) scr[(2 * i + (lane >> 5)) * 33 + (lane & 31)] = v[i];
    LDS_WAIT(); asm volatile("" ::: "memory");
    const int c = lane & 7;
    f32x4 g0 = {I.cscale, I.cscale, I.cscale, I.cscale}, g1 = g0;
    if (I.gain) { g0 = *(const GAS f32x4*)(I.gain + I.k0 + 8 * c) * I.cscale; g1 = *(const GAS f32x4*)(I.gain + I.k0 + 8 * c + 4) * I.cscale; }
#pragma unroll
    for (int j = 0; j < 4; ++j) { const int n = (lane >> 3) + 8 * j; const LAS float* s = scr + (8 * c) * 33 + n;
        v4u o; o.x = pk2(s[0 * 33] * g0[0], s[1 * 33] * g0[1]); o.y = pk2(s[2 * 33] * g0[2], s[3 * 33] * g0[3]); o.z = pk2(s[4 * 33] * g1[0], s[5 * 33] * g1[1]); o.w = pk2(s[6 * 33] * g1[2], s[7 * 33] * g1[3]);
        *(GAS v4u*)(I.WT + (size_t)(I.dst_row0 + n) * I.K + I.k0 + 8 * c) = o; }
    LDS_WAIT(); asm volatile("" ::: "memory");
}
struct Args { const float* in[11]; float* out; unsigned char* ws; int lo, hi, multi, pad; };

__device__ __forceinline__ void gates_naive(const bf16* xb, const float* Win, const float* g0, const float* bias, const float* ssq, float* ig, float* lf, int gtid, int gthreads) {
    for (int item = gtid; item < M * 8; item += gthreads) { const int row = item >> 3, j = item & 7; float s = 0.f;
        for (int k = 0; k < D; ++k) s += bf2f(xb[(size_t)row * D + k]) * g0[k] * Win[(size_t)k * MIN_COLS + 3072 + j];
        const float4 q = *(const float4*)(ssq + (size_t)row * 4); const float rs = 1.0f / sqrtf((q.x + q.y + q.z + q.w) * (1.0f / D) + EPS);
        float v = s * rs + bias[j]; v = GATE_CAP * tanhf(v / GATE_CAP);
        if (j < 4) ig[(size_t)row * 4 + j] = v; else lf[(size_t)row * 4 + (j - 4)] = fminf(v, 0.f) - log1pf(expf(-fabsf(v))); }
}
__device__ __forceinline__ void b1_naive(const bf16* kb, const bf16* vb, const float* ig, const float* lf, bf16* kvT, float* nloc, float* blast, float* mloc, LAS float* sm, int tid, int G) {
    LAS float* s_ig = sm; LAS float* s_lf = sm + 128; LAS float* s_b = sm + 256; LAS float* s_w = sm + 384;
    for (int u = blockIdx.x; u < NUNIT; u += G) {
        const int b = u >> 8, h = (u >> 6) & 3, c = u & 63; const size_t row0 = (size_t)b * SEQ + c * CH;
        if (tid < 128) { s_ig[tid] = ig[(row0 + tid) * 4 + h]; s_lf[tid] = lf[(row0 + tid) * 4 + h]; }
        __syncthreads();
        if (tid == 0) { float a = 0.f; for (int l = 0; l < 128; ++l) { a += s_lf[l]; s_b[l] = a; } const float bl = a; float mx = -INFINITY;
            for (int l = 0; l < 128; ++l) mx = fmaxf(mx, bl - s_b[l] + s_ig[l]);
            for (int l = 0; l < 128; ++l) s_w[l] = expf(bl - s_b[l] + s_ig[l] - mx);
            blast[u] = bl; mloc[u] = mx; }
        __syncthreads();
        const int d = tid & 127, eq = tid >> 7;
        for (int j = 0; j < 64; ++j) { const int e = eq + 4 * j; float s = 0.f;
            for (int l = 0; l < 128; ++l) s += s_w[l] * bf2f(kb[(row0 + l) * 512 + h * 128 + d]) * bf2f(vb[(row0 + l) * 1024 + h * 256 + e]);
            kvT[((size_t)u * 256 + e) * 128 + d] = (bf16)f2bf(s); }
        if (tid < 128) { float s = 0.f; for (int l = 0; l < 128; ++l) s += s_w[l] * bf2f(kb[(row0 + l) * 512 + h * 128 + tid]); nloc[(size_t)u * 128 + tid] = s; }
        __syncthreads();
    }
}
__device__ __forceinline__ void b2_naive(const bf16* kvT, bf16* CT, const float* nloc, float* nprev, const float* blast, const float* mloc, float* mprev, int gtid, int gthreads) {
    for (int idx = gtid; idx < 16 * 32768; idx += gthreads) { const int bh = idx >> 15, ed = idx & 32767; float m = 0.f, C = 0.f;
        for (int c = 0; c < NCH; ++c) { const int u = bh * 64 + c; const size_t off = (size_t)u * 32768 + ed; CT[off] = (bf16)f2bf(C);
            const float bl = blast[u], ml = mloc[u], mn = fmaxf(bl + m, ml), a = expf(bl + m - mn), s = expf(ml - mn); C = a * C + s * bf2f(kvT[off]); m = mn; } }
    for (int idx = gtid; idx < 16 * 128; idx += gthreads) { const int bh = idx >> 7, d = idx & 127; float m = 0.f, n = 0.f;
        for (int c = 0; c < NCH; ++c) { const int u = bh * 64 + c; nprev[(size_t)u * 128 + d] = n;
            const float bl = blast[u], ml = mloc[u], mn = fmaxf(bl + m, ml), a = expf(bl + m - mn), s = expf(ml - mn); n = a * n + s * nloc[(size_t)u * 128 + d]; m = mn; } }
    for (int idx = gtid; idx < 16; idx += gthreads) { float m = 0.f;
        for (int c = 0; c < NCH; ++c) { const int u = idx * 64 + c; mprev[u] = m; m = fmaxf(blast[u] + m, mloc[u]); } }
}
__device__ __forceinline__ void b3_naive(const bf16* qb, const bf16* kb, const bf16* vb, bf16* ob, const bf16* CT, const float* nprev, const float* mprev, const float* ig, const float* lf, const float* ghn,
                                         LAS float* sm, int tid, int G) {
    const int sb = tid >> 7, st = tid & 127;
    LAS float* s_a = sm + sb * 512; LAS float* s_P = s_a + 128; LAS float* s_red = s_a + 256; LAS float* s_misc = s_a + 384;
    const int niter = (M * NH) / (G * 4);
    for (int it = 0; it < niter; ++it) {
        const int item = (it * G + blockIdx.x) * 4 + sb; const int row = item >> 2, h = item & 3;
        const int b = row >> 13, tpos = row & 8191, c = tpos >> 7, tl = tpos & 127, unit = (b * 4 + h) * 64 + c; const size_t row0 = (size_t)row - tl;
        { float bs = 0.f; for (int l = 0; l <= st; ++l) bs += lf[(row0 + l) * 4 + h]; s_a[st] = ig[(row0 + st) * 4 + h] - bs; if (st == tl) s_misc[0] = bs; }
        __syncthreads();
        float cm = -INFINITY; for (int s = 0; s <= tl; ++s) cm = fmaxf(cm, s_a[s]);
        const float mp = mprev[unit], mm = fmaxf(cm, mp), bt = s_misc[0];
        const bf16* qrow = qb + (size_t)row * 512 + h * 128;
        { float dot = 0.f; const bf16* krow = kb + (row0 + st) * 512 + h * 128; for (int d = 0; d < 128; ++d) dot += bf2f(qrow[d]) * bf2f(krow[d]);
          s_P[st] = (st <= tl) ? dot * expf(s_a[st] - mm) : 0.f; }
        __syncthreads();
        const float inter = expf(mp - mm);
        float den = 0.f; for (int s = 0; s < 128; ++s) den += s_P[s];
        { float qn = 0.f; for (int d = 0; d < 128; ++d) qn += bf2f(qrow[d]) * nprev[(size_t)unit * 128 + d]; den += inter * qn; }
        const float dn = fmaxf(fabsf(den), expf(-(bt + mm)));
        float hv0, hv1;
        { const int e = st; float num = 0.f; for (int s = 0; s <= tl; ++s) num += s_P[s] * bf2f(vb[(row0 + s) * 1024 + h * 256 + e]);
          float qc = 0.f; const bf16* crow = CT + ((size_t)unit * 256 + e) * 128; for (int d = 0; d < 128; ++d) qc += bf2f(qrow[d]) * bf2f(crow[d]); hv0 = (num + inter * qc) / dn; }
        { const int e = st + 128; float num = 0.f; for (int s = 0; s <= tl; ++s) num += s_P[s] * bf2f(vb[(row0 + s) * 1024 + h * 256 + e]);
          float qc = 0.f; const bf16* crow = CT + ((size_t)unit * 256 + e) * 128; for (int d = 0; d < 128; ++d) qc += bf2f(qrow[d]) * bf2f(crow[d]); hv1 = (num + inter * qc) / dn; }
        s_red[st] = hv0 * hv0 + hv1 * hv1;
        __syncthreads();
        float ss = 0.f; for (int i = 0; i < 128; ++i) ss += s_red[i];
        const float rn = 1.0f / sqrtf(ss * (1.0f / 256.0f) + EPS);
        { const size_t oi = (size_t)row * 1024 + h * 256 + st; ob[oi] = (bf16)f2bf(hv0 * rn * ghn[h * 256 + st] * bf2f(ob[oi])); }
        { const size_t oi = (size_t)row * 1024 + h * 256 + st + 128; ob[oi] = (bf16)f2bf(hv1 * rn * ghn[h * 256 + st + 128] * bf2f(ob[oi])); }
        __syncthreads();
    }
}
__device__ __forceinline__ void conv_phase(bf16* bg, const bf16* ub, const float* wc, int ibase, int lt) {
    for (int li = lt; li < 131072; li += 32 * NT) { const int idx = ibase + li; const int r0 = (idx >> 7) * 4, ch0 = (idx & 127) * 8, t0 = r0 & (SEQ - 1);
        const v4u z = {0u, 0u, 0u, 0u};
        v4u uu[6], bb[4];
        uu[0] = t0 >= 2 ? *(const GAS v4u*)(ub + (size_t)(r0 - 2) * D + ch0) : z; uu[1] = t0 >= 2 ? *(const GAS v4u*)(ub + (size_t)(r0 - 1) * D + ch0) : z;
#pragma unroll
        for (int i = 0; i < 4; ++i) { uu[2 + i] = *(const GAS v4u*)(ub + (size_t)(r0 + i) * D + ch0); bb[i] = *(const GAS v4u*)(bg + (size_t)(r0 + i) * D + ch0); }
        const f32x4 w0a = *(const GAS f32x4*)(wc + ch0), w0b = *(const GAS f32x4*)(wc + ch0 + 4), w1a = *(const GAS f32x4*)(wc + D + ch0), w1b = *(const GAS f32x4*)(wc + D + ch0 + 4);
        const f32x4 w2a = *(const GAS f32x4*)(wc + 2 * D + ch0), w2b = *(const GAS f32x4*)(wc + 2 * D + ch0 + 4);
#pragma unroll
        for (int i = 0; i < 4; ++i) { v4u o;
#pragma unroll
            for (int j = 0; j < 4; ++j) { const float wl0 = j < 2 ? w0a[2 * j] : w0b[2 * j - 4], wh0 = j < 2 ? w0a[2 * j + 1] : w0b[2 * j - 3], wl1 = j < 2 ? w1a[2 * j] : w1b[2 * j - 4], wh1 = j < 2 ? w1a[2 * j + 1] : w1b[2 * j - 3];
                const float wl2 = j < 2 ? w2a[2 * j] : w2b[2 * j - 4], wh2 = j < 2 ? w2a[2 * j + 1] : w2b[2 * j - 3];
                const unsigned a = uu[2 + i][j], b1 = uu[1 + i][j], c2 = uu[i][j], gg = bb[i][j];
                const float y0 = __uint_as_float(gg << 16) * (wl0 * __uint_as_float(c2 << 16) + wl1 * __uint_as_float(b1 << 16) + wl2 * __uint_as_float(a << 16));
                const float y1 = __uint_as_float(gg & 0xffff0000u) * (wh0 * __uint_as_float(c2 & 0xffff0000u) + wh1 * __uint_as_float(b1 & 0xffff0000u) + wh2 * __uint_as_float(a & 0xffff0000u));
                o[j] = pk2(y0, y1); }
            *(GAS v4u*)(bg + (size_t)(r0 + i) * D + ch0) = o; }
    }
}
__device__ __forceinline__ void postnorm_naive(float* hout, bf16* xb, const float* g, float* ssq, bool last, int gw, int ngw, int lane) {
    for (int row = gw; row < M; row += ngw) {
        float* hr = hout + (size_t)row * D; bf16* xr = xb + (size_t)row * D;
        f32x4 hv[4]; float s = 0.f;
#pragma unroll
        for (int j = 0; j < 4; ++j) { hv[j] = *(const GAS f32x4*)(hr + 4 * lane + 256 * j); s += (hv[j][0] * hv[j][0] + hv[j][1] * hv[j][1]) + (hv[j][2] * hv[j][2] + hv[j][3] * hv[j][3]); }
        const float c = 1.0f / sqrtf(wave_sum(s) * (1.0f / D) + EPS); float s2 = 0.f;
#pragma unroll
        for (int j = 0; j < 4; ++j) { const int col = 4 * lane + 256 * j; const unsigned long long xw = *(const GAS unsigned long long*)(xr + col); const f32x4 gv = *(const GAS f32x4*)(g + col);
            const unsigned lo = (unsigned)xw, hi = (unsigned)(xw >> 32);
            f32x4 xn; xn[0] = __uint_as_float(lo << 16) + c * hv[j][0] * gv[0]; xn[1] = __uint_as_float(lo & 0xffff0000u) + c * hv[j][1] * gv[1];
            xn[2] = __uint_as_float(hi << 16) + c * hv[j][2] * gv[2]; xn[3] = __uint_as_float(hi & 0xffff0000u) + c * hv[j][3] * gv[3];
            const unsigned p0 = pk2(xn[0], xn[1]), p1 = pk2(xn[2], xn[3]);
            const float r0 = __uint_as_float(p0 << 16), r1 = __uint_as_float(p0 & 0xffff0000u), r2 = __uint_as_float(p1 << 16), r3 = __uint_as_float(p1 & 0xffff0000u);
            s2 += (r0 * r0 + r1 * r1) + (r2 * r2 + r3 * r3);
            *(GAS unsigned long long*)(xr + col) = (unsigned long long)p0 | ((unsigned long long)p1 << 32);
            if (last) *(GAS f32x4*)(hr + col) = xn; }
        s2 = wave_sum(s2);
        if (lane == 0) *(GAS f32x4*)(ssq + (size_t)row * 4) = (f32x4){s2, 0.f, 0.f, 0.f};
    }
}


typedef short s16x4 __attribute__((ext_vector_type(4)));
typedef short v4i16_t __attribute__((ext_vector_type(4)));
typedef unsigned u32x2v __attribute__((ext_vector_type(2)));
__device__ __forceinline__ s16x4 tr16(LAS const unsigned char* p) { return __builtin_bit_cast(s16x4, __builtin_amdgcn_ds_read_tr16_b64_v4i16((LAS v4i16_t*)p)); }
__device__ __forceinline__ bf16x8 cat8(s16x4 lo, s16x4 hi) { return (bf16x8){lo[0], lo[1], lo[2], lo[3], hi[0], hi[1], hi[2], hi[3]}; }
#define MFMA16(a, b, c) __builtin_amdgcn_mfma_f32_16x16x32_bf16(a, b, c, 0, 0, 0)
constexpr int KP = 288, VP = 544;
constexpr int LDS_KS = 0, LDS_VS = 128 * KP, LDS_SC = LDS_VS + 128 * VP;
static_assert(LDS_SC + 2048 + 4096 <= RING_BYTES, "mLSTM LDS map");
__device__ __forceinline__ float wave_incl_sum(float s, int lane) {
#pragma unroll
    for (int o = 1; o < 64; o <<= 1) { const float t = __shfl_up(s, o); if (lane >= o) s += t; }
    return s;
}
__device__ __forceinline__ float wave_incl_max(float s, int lane) {
#pragma unroll
    for (int o = 1; o < 64; o <<= 1) { const float t = __shfl_up(s, o); if (lane >= o) s = fmaxf(s, t); }
    return s;
}
__device__ __forceinline__ float wave_max(float v) {
#pragma unroll
    for (int o = 1; o < 64; o <<= 1) v = fmaxf(v, __shfl_xor(v, o));
    return v;
}
__device__ __forceinline__ void stage_load(const bf16* kbase, const bf16* vbase, v4u (&tk)[4], v4u (&tv)[8], int tl) {
    const unsigned ko = (unsigned)((tl >> 4) * 512 + (tl & 15) * 8), vo = (unsigned)((tl >> 5) * 1024 + (tl & 31) * 8);
#pragma unroll
    for (int i = 0; i < 4; ++i) tk[i] = *(const GAS v4u*)(kbase + (ko + (unsigned)(i * 32 * 512)));
#pragma unroll
    for (int i = 0; i < 8; ++i) tv[i] = *(const GAS v4u*)(vbase + (vo + (unsigned)(i * 16 * 1024)));
}
template <bool SCALE> __device__ __forceinline__ void stage_store(v4u (&tk)[4], const v4u (&tv)[8], LAS unsigned char* L, const LAS float* s_w, int tl) {
    const int r4 = tl >> 4, c8k = tl & 15, r5 = tl >> 5, c8v = tl & 31;
#pragma unroll
    for (int i = 0; i < 4; ++i) { const int r = r4 + 32 * i;
        if (SCALE) { const float w = s_w[r];
#pragma unroll
            for (int j = 0; j < 4; ++j) tk[i][j] = pk2(__uint_as_float(tk[i][j] << 16) * w, __uint_as_float(tk[i][j] & 0xffff0000u) * w); }
        *(LAS v4u*)(L + LDS_KS + r * KP + c8k * 16) = tk[i]; }
#pragma unroll
    for (int i = 0; i < 8; ++i) *(LAS v4u*)(L + LDS_VS + (r5 + 16 * i) * VP + c8v * 16) = tv[i];
}
__device__ __forceinline__ int mixer_unit(int vc, int i) { const int jj = (vc >> 3) * 4 + i; return (((vc & 7) >> 1) * 4 + (jj & 3)) * 64 + 32 * (vc & 1) + (jj >> 2); }
__device__ __forceinline__ void b1_fast(const bf16* kb, const bf16* vb, const float* ig, const float* lf, bf16* kvT, float* nloc, float* blast, float* mloc, LAS unsigned char* L, int tid, int vc) {
    LAS float* s_w = (LAS float*)(L + LDS_SC);
    for (int ui = 0; ui < 4; ++ui) { const int u = mixer_unit(vc, ui);
        const int tl = launder_i(tid);
        const int lane = tl & 63, wave = __builtin_amdgcn_readfirstlane(tl >> 6), g = lane >> 4, c16 = lane & 15, q = (lane >> 2) & 3, p = lane & 3;
        const int b = u >> 8, h = (u >> 6) & 3, c = u & 63; const size_t row0 = (size_t)b * SEQ + c * CH;
        v4u tk[4], tv[8];
        stage_load(kb + row0 * 512 + h * 128, vb + row0 * 1024 + h * 256, tk, tv, tl);
        if (wave == 0) {
            const float* lfp = lf + row0 * 4 + h; const float* igp = ig + row0 * 4 + h;
            const float x0 = lfp[8 * lane], x1 = lfp[8 * lane + 4], i0 = igp[8 * lane], i1 = igp[8 * lane + 4];
            const float sc = wave_incl_sum(x0 + x1, lane), ex = sc - (x0 + x1), b0 = ex + x0, b1 = sc, bl = __int_as_float(__builtin_amdgcn_readlane(__float_as_int(sc), 63));
            const float lw0 = bl - b0 + i0, lw1 = bl - b1 + i1, mx = wave_max(fmaxf(lw0, lw1));
            s_w[2 * lane] = expf(lw0 - mx); s_w[2 * lane + 1] = expf(lw1 - mx);
            if (lane == 0) { blast[u * 32] = bl; mloc[u * 32] = mx; }
        }
        __syncthreads();
        stage_store<true>(tk, tv, L, s_w, tl);
        __syncthreads();
        const short one = (c16 == 0) ? (short)0x3F80 : (short)0; const bf16x8 ones = {one, one, one, one, one, one, one, one};
        f32x4 acc[8][2], accn = {0.f, 0.f, 0.f, 0.f};
#pragma unroll
        for (int dt = 0; dt < 8; ++dt) { acc[dt][0] = (f32x4){0.f, 0.f, 0.f, 0.f}; acc[dt][1] = (f32x4){0.f, 0.f, 0.f, 0.f}; }
        const LAS unsigned char* vbp = L + LDS_VS + (4 * g + q) * VP + (32 * wave + 4 * p) * 2;
        const LAS unsigned char* kbp = L + LDS_KS + (4 * g + q) * KP + (4 * p) * 2;
#pragma unroll
        for (int ks = 0; ks < 4; ++ks) { bf16x8 vf[2];
#pragma unroll
            for (int et = 0; et < 2; ++et) { const LAS unsigned char* bp = vbp + 32 * ks * VP + 32 * et; vf[et] = cat8(tr16(bp), tr16(bp + 16 * VP)); }
#pragma unroll
            for (int dt = 0; dt < 8; ++dt) { const LAS unsigned char* bp = kbp + 32 * ks * KP + 32 * dt; const bf16x8 kf = cat8(tr16(bp), tr16(bp + 16 * KP));
                acc[dt][0] = MFMA16(kf, vf[0], acc[dt][0]); acc[dt][1] = MFMA16(kf, vf[1], acc[dt][1]); }
        }
#pragma unroll
        for (int ks = 0; ks < 4; ++ks) { const LAS unsigned char* bp = kbp + 32 * ks * KP + 32 * wave; accn = MFMA16(cat8(tr16(bp), tr16(bp + 16 * KP)), ones, accn); }
        bf16* kvu = kvT + (size_t)u * 32768; const unsigned so = (unsigned)((8 * wave * 64 + 16 * (g >> 1) + c16) * 8 + 4 * (g & 1));
#pragma unroll
        for (int dt = 0; dt < 8; ++dt)
#pragma unroll
            for (int et = 0; et < 2; ++et) { u32x2v w; w.x = pk2(acc[dt][et][0], acc[dt][et][1]); w.y = pk2(acc[dt][et][2], acc[dt][et][3]);
                *(GAS u32x2v*)(kvu + (so + (unsigned)(((et * 4 + (dt >> 1)) * 64 + 32 * (dt & 1)) * 8))) = w; }
        if (c16 == 0) *(GAS f32x4*)(nloc + (size_t)u * 128 + 16 * wave + 4 * g) = accn;
        __syncthreads();
    }
}
__device__ __forceinline__ void b2_fast(const bf16* kvT, bf16* CT, const float* nloc, bf16* NPB, const float* blast, const float* mloc, float* mprev, LAS unsigned char* L, int tid, int item0, int G) {
    LAS float* s_a = (LAS float*)L; LAS float* s_s = s_a + 64; LAS float* s_bl = s_a + 128; LAS float* s_ml = s_a + 192;
    for (int item = item0; item < 256; item += G) { const int bh = item >> 4, part = item & 15;
        if (tid < 64) {
            const float bl = blast[(bh * 64 + tid) * 32], ml = mloc[(bh * 64 + tid) * 32]; float A = bl, B = ml;
#pragma unroll
            for (int o = 1; o < 64; o <<= 1) { const float Ap = __shfl_up(A, o), Bp = __shfl_up(B, o); if (tid >= o) { B = fmaxf(Bp + A, B); A = Ap + A; } }
            const float mn = fmaxf(A, B);
            float m = __shfl_up(mn, 1); if (tid == 0) m = 0.f;
            s_a[tid] = expf(bl + m - mn); s_s[tid] = expf(ml - mn); if (part == 0) mprev[bh * 64 + tid] = m; }
        __syncthreads();
        if (tid < 256) {
            const size_t off = (size_t)bh * 64 * 32768 + part * 2048 + tid * 8;
            float C[8];
#pragma unroll
            for (int j = 0; j < 8; ++j) C[j] = 0.f;
            for (int c0 = 0; c0 < NCH; c0 += 16) {
                v4u kvb[16];
#pragma unroll
                for (int i = 0; i < 16; ++i) kvb[i] = *(const GAS v4u*)(kvT + off + (size_t)(c0 + i) * 32768);
#pragma unroll
                for (int i = 0; i < 16; ++i) { const int c = c0 + i; const v4u kv = kvb[i];
                    v4u o; o.x = pk2(C[0], C[1]); o.y = pk2(C[2], C[3]); o.z = pk2(C[4], C[5]); o.w = pk2(C[6], C[7]); *(GAS v4u*)(CT + off + (size_t)c * 32768) = o;
                    const float a = s_a[c], sv = s_s[c];
#pragma unroll
                    for (int j = 0; j < 4; ++j) { C[2 * j] = a * C[2 * j] + sv * __uint_as_float(kv[j] << 16); C[2 * j + 1] = a * C[2 * j + 1] + sv * __uint_as_float(kv[j] & 0xffff0000u); } } }
        } else if (part == 0 && tid < 384) { const int d = tid - 256; float n = 0.f;
            for (int c0 = 0; c0 < NCH; c0 += 16) { float nl[16];
#pragma unroll
                for (int i = 0; i < 16; ++i) nl[i] = nloc[(size_t)(bh * 64 + c0 + i) * 128 + d];
#pragma unroll
                for (int i = 0; i < 16; ++i) { const int c = c0 + i; NPB[(size_t)(bh * 64 + c) * 128 + d] = (bf16)f2bf(n); n = s_a[c] * n + s_s[c] * nl[i]; } } }
        __syncthreads();
    }
}
__device__ __forceinline__ void b3_fast(const bf16* qb, const bf16* kb, const bf16* vb, bf16* ob, const bf16* CT, const bf16* NPB, const float* mprev, const float* ig, const float* lf, const float* ghn,
                                        LAS unsigned char* L, int tid, int vc) {
    LAS float* s_a = (LAS float*)(L + LDS_SC); LAS float* s_mm = s_a + 128; LAS float* s_bm = s_a + 256;
    LAS float* s_gh = (LAS float*)(L + LDS_SC + 2048);
    for (int i = tid; i < 256; i += NT) *(LAS f32x4*)(s_gh + 4 * i) = *(const GAS f32x4*)(ghn + 4 * i);
    v4u tk[4], tv[8]; bf16x8 qn[4]; float px0 = 0.f, px1 = 0.f, pi0 = 0.f, pi1 = 0.f;
#define B3_PREFETCH(un) do { const int tl_ = launder_i(tid); const int b_ = (un) >> 8, h_ = ((un) >> 6) & 3, c_ = (un) & 63; const size_t r_ = (size_t)b_ * SEQ + c_ * CH; \
        stage_load(kb + r_ * 512 + h_ * 128, vb + r_ * 1024 + h_ * 256, tk, tv, tl_); \
        { const bf16* qbase_ = qb + r_ * 512 + h_ * 128; const unsigned qo_ = (unsigned)((16 * (tl_ >> 6) + (tl_ & 15)) * 512 + 8 * ((tl_ & 63) >> 4)); \
          _Pragma("unroll") for (int ks = 0; ks < 4; ++ks) qn[ks] = *(const GAS bf16x8*)(qbase_ + (qo_ + 32u * ks)); } \
        if (tl_ < 64) { const float* lfp_ = lf + r_ * 4 + h_; const float* igp_ = ig + r_ * 4 + h_; px0 = lfp_[8 * tl_]; px1 = lfp_[8 * tl_ + 4]; pi0 = igp_[8 * tl_]; pi1 = igp_[8 * tl_ + 4]; } } while (0)
    { const int u_first = mixer_unit(vc, 3); B3_PREFETCH(u_first); }
    for (int ui = 3; ui >= 0; --ui) { const int u = mixer_unit(vc, ui);
        const int tl = launder_i(tid);
        const int lane = tl & 63, wave = __builtin_amdgcn_readfirstlane(tl >> 6), g = lane >> 4, c16 = lane & 15, q = (lane >> 2) & 3, p = lane & 3;
        const int b = u >> 8, h = (u >> 6) & 3, c = u & 63; const size_t row0 = (size_t)b * SEQ + c * CH;
        const float mp = mprev[u];
        const int t = 16 * wave + c16;
        bf16x8 qf[4];
#pragma unroll
        for (int ks = 0; ks < 4; ++ks) qf[ks] = qn[ks];
        const bf16* ctb = CT + (size_t)u * 32768; const unsigned coff = (unsigned)(lane * 8);
        bf16x8 cf[3][4];
#pragma unroll
        for (int pe = 0; pe < 2; ++pe)
#pragma unroll
            for (int ks = 0; ks < 4; ++ks) cf[pe][ks] = *(const GAS bf16x8*)(ctb + (coff + (unsigned)((pe * 4 + ks) * 512)));
        if (wave == 0) {
            const float x0 = px0, x1 = px1, i0 = pi0, i1 = pi1;
            const float sc = wave_incl_sum(x0 + x1, lane), ex = sc - (x0 + x1), b0 = ex + x0, b1 = sc;
            const float a0 = i0 - b0, a1 = i1 - b1, cmx = wave_incl_max(fmaxf(a0, a1), lane);
            float pe = __shfl_up(cmx, 1); if (lane == 0) pe = -INFINITY;
            const float mm0 = fmaxf(fmaxf(pe, a0), mp), mm1 = fmaxf(cmx, mp);
            s_a[2 * lane] = a0; s_a[2 * lane + 1] = a1; s_mm[2 * lane] = mm0; s_mm[2 * lane + 1] = mm1; s_bm[2 * lane] = b0 + mm0; s_bm[2 * lane + 1] = b1 + mm1;
        }
        stage_store<false>(tk, tv, L, nullptr, tl);
        __syncthreads();
        const float mm_t = s_mm[t], bm_t = s_bm[t], inter_t = expf(mp - mm_t);
        const short one = (c16 == 0) ? (short)0x3F80 : (short)0; const bf16x8 ones = {one, one, one, one, one, one, one, one};
        f32x4 acc[16], accn = {0.f, 0.f, 0.f, 0.f};
#pragma unroll
        for (int et = 0; et < 16; ++et) acc[et] = (f32x4){0.f, 0.f, 0.f, 0.f};
#pragma unroll
        for (int et = 0; et < 16; ++et) {
            if (et + 2 < 16) {
#pragma unroll
                for (int ks = 0; ks < 4; ++ks) cf[(et + 2) % 3][ks] = *(const GAS bf16x8*)(ctb + (coff + (unsigned)(((et + 2) * 4 + ks) * 512))); }
#pragma unroll
            for (int ks = 0; ks < 4; ++ks) acc[et] = MFMA16(cf[et % 3][ks], qf[ks], acc[et]);
        }
        bf16* obase = ob + (row0 + 16 * wave) * 1024 + h * 256; const unsigned oo = (unsigned)((lane >> 5) * 1024 + (lane & 31) * 8);
        v4u sg[8];
#pragma unroll
        for (int i = 0; i < 8; ++i) sg[i] = *(const GAS v4u*)(obase + (oo + 2048u * i));
        { const bf16* npb = NPB + (size_t)u * 128;
#pragma unroll
          for (int ks = 0; ks < 4; ++ks) { bf16x8 nf = *(const GAS bf16x8*)(npb + (32 * ks + 8 * g)); if (c16 != 0) nf = (bf16x8){0, 0, 0, 0, 0, 0, 0, 0}; accn = MFMA16(nf, qf[ks], accn); } }
#pragma unroll
        for (int et = 0; et < 16; ++et) acc[et] = acc[et] * inter_t;
        accn = accn * inter_t;
        if (ui > 0) { const int un = mixer_unit(vc, ui - 1); B3_PREFETCH(un); }
        const LAS unsigned char* kbp = L + LDS_KS + c16 * KP + 16 * g;
        const LAS unsigned char* vbp = L + LDS_VS + (4 * g + q) * VP + 8 * p;
        for (int ss = 0; ss <= (wave >> 1); ++ss) { const int s0 = 32 * ss;
            f32x4 X0 = {0.f, 0.f, 0.f, 0.f}, X1 = {0.f, 0.f, 0.f, 0.f};
#pragma unroll
            for (int ks = 0; ks < 4; ++ks) { const bf16x8 k0f = *(const LAS bf16x8*)(kbp + s0 * KP + 64 * ks), k1f = *(const LAS bf16x8*)(kbp + (s0 + 16) * KP + 64 * ks);
                X0 = MFMA16(k0f, qf[ks], X0); X1 = MFMA16(k1f, qf[ks], X1); }
            const f32x4 a40 = *(const LAS f32x4*)(s_a + s0 + 4 * g), a41 = *(const LAS f32x4*)(s_a + s0 + 16 + 4 * g);
            float P0[4], P1[4];
#pragma unroll
            for (int r = 0; r < 4; ++r) { const int s = s0 + 4 * g + r; P0[r] = (s <= t) ? X0[r] * __expf(a40[r] - mm_t) : 0.f; P1[r] = (s + 16 <= t) ? X1[r] * __expf(a41[r] - mm_t) : 0.f;   }
            v4u pw; pw.x = pk2(P0[0], P0[1]); pw.y = pk2(P0[2], P0[3]); pw.z = pk2(P1[0], P1[1]); pw.w = pk2(P1[2], P1[3]);
            const bf16x8 pf = __builtin_bit_cast(bf16x8, pw);
#pragma unroll
            for (int et = 0; et < 16; ++et) { const LAS unsigned char* bp = vbp + s0 * VP + 32 * et; const bf16x8 vf = cat8(tr16(bp), tr16(bp + 16 * VP)); acc[et] = MFMA16(vf, pf, acc[et]); }
            accn = MFMA16(ones, pf, accn);
        }
        const float den = __shfl(accn[0], c16), dn = fmaxf(fabsf(den), expf(-bm_t)), inv = 1.0f / dn;
        float ssq = 0.f;
#pragma unroll
        for (int et = 0; et < 16; ++et) { acc[et] = acc[et] * inv; ssq += (acc[et][0] * acc[et][0] + acc[et][1] * acc[et][1]) + (acc[et][2] * acc[et][2] + acc[et][3] * acc[et][3]); }
        ssq += __shfl_xor(ssq, 16); ssq += __shfl_xor(ssq, 32);
        const float rn = 1.0f / sqrtf(ssq * (1.0f / 256.0f) + EPS);
        __syncthreads();
        LAS unsigned char* ost = L + LDS_VS + wave * (16 * 528);
#pragma unroll
        for (int et = 0; et < 16; ++et) { const f32x4 gh = *(const LAS f32x4*)(s_gh + h * 256 + 16 * et + 4 * g);
            u32x2v w; w.x = pk2(acc[et][0] * rn * gh[0], acc[et][1] * rn * gh[1]); w.y = pk2(acc[et][2] * rn * gh[2], acc[et][3] * rn * gh[3]);
            *(LAS u32x2v*)(ost + c16 * 528 + (16 * et + 4 * g) * 2) = w; }
        LDS_WAIT(); asm volatile("" ::: "memory");
#pragma unroll
        for (int i = 0; i < 8; ++i) { const v4u hv = *(const LAS v4u*)(ost + ((lane >> 5) + 2 * i) * 528 + (lane & 31) * 16); v4u o;
#pragma unroll
            for (int j = 0; j < 4; ++j) o[j] = pk2(__uint_as_float(hv[j] << 16) * __uint_as_float(sg[i][j] << 16), __uint_as_float(hv[j] & 0xffff0000u) * __uint_as_float(sg[i][j] & 0xffff0000u));
            *(GAS v4u*)(obase + (oo + 2048u * i)) = o; }
        __syncthreads();
    }
#undef B3_PREFETCH
}
__device__ __forceinline__ void gates_fast(const bf16* xb, const bf16* wgT, const float* bias, const float* ssq, float* ig, float* lf, int gw, int ngw, int lane) {
    const int g = lane >> 4, c16 = lane & 15;
    for (int tile = gw; tile < M / 16; tile += ngw) { const size_t row = (size_t)tile * 16 + c16; f32x4 acc = {0.f, 0.f, 0.f, 0.f};
#pragma unroll 8
        for (int ks = 0; ks < 32; ++ks) { const bf16x8 wf = *(const GAS bf16x8*)(wgT + c16 * D + 32 * ks + 8 * g), xf = *(const GAS bf16x8*)(xb + row * D + 32 * ks + 8 * g); acc = MFMA16(wf, xf, acc); }
        const float rs = 1.0f / sqrtf(((ssq[row] + ssq[M + row]) + (ssq[2 * M + row] + ssq[3 * M + row])) * (1.0f / D) + EPS);
        if (g < 2) { f32x4 o;
#pragma unroll
            for (int r = 0; r < 4; ++r) { float v = acc[r] * rs + bias[4 * g + r]; v = GATE_CAP * tanhf(v * (1.0f / GATE_CAP)); o[r] = (g == 0) ? v : (fminf(v, 0.f) - log1pf(expf(-fabsf(v)))); }
            *(GAS f32x4*)((g == 0 ? ig : lf) + row * 4) = o; }
    }
}

#define XB_LSUB(j)  (3520 + 64 * (j))
#define XB_LGEN(j)  (4544 + 64 * (j))
__device__ __forceinline__ XcdBarrier xcd_barrier_post_rank(unsigned* bar, volatile LAS unsigned* st, volatile LAS unsigned* rank_word, unsigned wv) {
    XcdBarrier b; b.wv = wv; b.bar = bar; b.x = xb_xcc_id(); b.st = st;
    if (XB_T0(b)) *rank_word = xb_add(&bar[XB_XCNT(b.x)], 1u);
    return b;
}
#define XB_LSLOT(j) (8192 + 32 * (j))
__device__ __forceinline__ void xcd_local_barrier(const XcdBarrier& b, volatile LAS unsigned* rankw, volatile LAS unsigned* genw) {
    asm volatile("s_waitcnt vmcnt(0)" ::: "memory");
    __syncthreads();
    if (b.wv == 0u) {
        unsigned* line = b.bar + XB_LSLOT(b.x); const unsigned l = xb_lane_now();
        const unsigned rank = (unsigned)__builtin_amdgcn_readfirstlane((int)*rankw), gen = (unsigned)__builtin_amdgcn_readfirstlane((int)*genw) + 1u;
        __builtin_amdgcn_s_waitcnt(0);
        if (l == 0u) { *genw = gen; __hip_atomic_store(line + rank, gen, __ATOMIC_RELAXED, __HIP_MEMORY_SCOPE_WORKGROUP); }
        unsigned sp = 0u;
        for (;;) {
            const unsigned v = __hip_atomic_load(line + (l & 31u), __ATOMIC_RELAXED, __HIP_MEMORY_SCOPE_AGENT);
            if (__builtin_amdgcn_ballot_w64((int)(v - gen) >= 0) == ~0ull) break;
            __builtin_amdgcn_s_sleep(1);
            if ((++sp & 255u) == 0u) { if (xb_ld(&b.bar[XB_TMO])) break; if (sp > XB_SPIN_CAP) { atomicAdd(&b.bar[XB_TMO], 1u); break; } } }
        __builtin_amdgcn_fence(__ATOMIC_ACQUIRE, "agent");
        asm volatile("s_waitcnt vmcnt(0)" ::: "memory");
    }
    __syncthreads();
}
#define XB_GSLOT(j) (8448 + 32 * (j))
#define XB_GREL(j)  (8704 + 32 * (j))
#define XB_WDONE    9728
#define XB_PTOP(p)  (9216 + 64 * (p))
#define XB_PGEN(p)  (9472 + 64 * (p))
__device__ __forceinline__ void xcd_pair_barrier(const XcdBarrier& b, volatile LAS unsigned* rankw, volatile LAS unsigned* genw) {
    asm volatile("s_waitcnt vmcnt(0)" ::: "memory");
    __syncthreads();
    if (b.wv == 0u) {
        unsigned* bar = b.bar; unsigned* line = bar + XB_GSLOT(b.x); unsigned* rel = bar + XB_GREL(b.x); const unsigned l = xb_lane_now();
        const unsigned rank = (unsigned)__builtin_amdgcn_readfirstlane((int)*rankw), gen = (unsigned)__builtin_amdgcn_readfirstlane((int)*genw) + 1u;
        __builtin_amdgcn_s_waitcnt(0);
        if (l == 0u) { *genw = gen; __hip_atomic_store(line + rank, gen, __ATOMIC_RELAXED, __HIP_MEMORY_SCOPE_WORKGROUP); }
        unsigned sp = 0u;
        if (rank == 0u) {
            for (;;) {
                const unsigned v = __hip_atomic_load(line + (l & 31u), __ATOMIC_RELAXED, __HIP_MEMORY_SCOPE_AGENT);
                if (__builtin_amdgcn_ballot_w64((int)(v - gen) >= 0) == ~0ull) break;
                __builtin_amdgcn_s_sleep(1);
                if ((++sp & 255u) == 0u) { if (xb_ld(&bar[XB_TMO])) break; if (sp > XB_SPIN_CAP) { atomicAdd(&bar[XB_TMO], 1u); break; } } }
            __builtin_amdgcn_fence(__ATOMIC_RELEASE, "agent");
            asm volatile("s_waitcnt vmcnt(0)" ::: "memory");
            if (l == 0u) { const unsigned pr = b.x >> 1, og = xb_add(&bar[XB_PTOP(pr)], 1u), tg = og / 2u;
                if (og + 1u == (tg + 1u) * 2u) xb_add(&bar[XB_PGEN(pr)], 1u);
                else XB_SPIN(xb_ld(&bar[XB_PGEN(pr)]) == tg, bar); }
            __builtin_amdgcn_fence(__ATOMIC_ACQUIRE, "agent");
            if (l == 0u) __hip_atomic_store(rel, gen, __ATOMIC_RELAXED, __HIP_MEMORY_SCOPE_WORKGROUP);
            asm volatile("s_waitcnt vmcnt(0)" ::: "memory");
        } else {
            for (;;) {
                const unsigned v = __hip_atomic_load(rel, __ATOMIC_RELAXED, __HIP_MEMORY_SCOPE_AGENT);
                if ((int)((unsigned)__builtin_amdgcn_readfirstlane((int)v) - gen) >= 0) break;
                __builtin_amdgcn_s_sleep(1);
                if ((++sp & 255u) == 0u) { if (xb_ld(&bar[XB_TMO])) break; if (sp > XB_SPIN_CAP) { atomicAdd(&bar[XB_TMO], 1u); break; } } }
            __builtin_amdgcn_fence(__ATOMIC_ACQUIRE, "agent");
            asm volatile("s_waitcnt vmcnt(0)" ::: "memory");
        }
    }
    __syncthreads();
}
#define BSEL_() ({ int t_ = bsel; asm volatile("" : "+s"(t_)); (size_t)t_; })
#define SP_(OFFC, OFFB, ROWB) ((bf16*)(ws + WS_S + (xmode ? (size_t)(OFFB) : (size_t)(OFFC)) + BSEL_() * (size_t)(80 * MiB - (size_t)(ROWB))))
#define hid SP_(0, 0, (size_t)SEQ * FF * 2)
#define qb  SP_(0, 0, (size_t)SEQ * 512 * 2)
#define kb  SP_(32 * MiB, 8 * MiB, (size_t)SEQ * 512 * 2)
#define vb  SP_(64 * MiB, 16 * MiB, (size_t)SEQ * 1024 * 2)
#define ob  SP_(128 * MiB, 32 * MiB, (size_t)SEQ * 1024 * 2)
#define kvT SP_(192 * MiB, 48 * MiB, (size_t)NH * NCH * 32768 * 2)
#define CT  SP_(256 * MiB, 64 * MiB, (size_t)NH * NCH * 32768 * 2)
#define bgb SP_(0, 0, (size_t)SEQ * 1024 * 2)
#define ub  SP_(64 * MiB, 16 * MiB, (size_t)SEQ * 1024 * 2)
__global__ void __launch_bounds__(NT, 2) mk_fwd(Args args) {
    extern __shared__ __attribute__((aligned(16))) unsigned char lds[];
    LAS unsigned char* L = (LAS unsigned char*)lds;
    volatile LAS unsigned* MISC = (volatile LAS unsigned*)(L + MISC_OFF);
    const int tid = threadIdx.x, lane = tid & 63, wave = __builtin_amdgcn_readfirstlane(tid >> 6), G = gridDim.x;
    const int gtid = blockIdx.x * NT + tid, gthreads = G * NT, gw = blockIdx.x * NWAVES + wave, ngw = G * NWAVES;
    unsigned char* ws = args.ws;
    gu32* ctl = (gu32*)(ws + WS_CTL);
    const float* x_in = args.in[0]; const float* norm_g = args.in[1]; const float* w_in_m = args.in[2]; const float* b_gates = args.in[3]; const float* g_hnorm = args.in[4];
    const float* w_out_m = args.in[5]; const float* w_in_c = args.in[6]; const float* w_conv = args.in[7]; const float* w_out_c = args.in[8]; const float* w_up = args.in[9]; const float* w_dn = args.in[10];
    float* ssq = (float*)(ws + WS_SSQ); float* igp = (float*)(ws + WS_IG); float* lfp = (float*)(ws + WS_LF);
    float* blast = (float*)(ws + WS_BLAST); float* mloc = (float*)(ws + WS_MLOC); float* mprev = (float*)(ws + WS_MPREV);
    float* nloc = (float*)(ws + WS_NLOC); float* nprev = (float*)(ws + WS_NPREV); bf16* NPB = (bf16*)(ws + WS_NPREV); bf16* wgT = (bf16*)(ws + WS_WGT);
    bf16* xb = (bf16*)(ws + WS_XB);
    for (int u = tid; u < (LDS_BYTES - LDSCTL_OFF) / 4; u += NT) ((LAS unsigned*)(L + LDSCTL_OFF))[u] = 0u;
    __syncthreads();
#define TIDN (wave * 64 + (int)xb_lane_now())
    const int lo = args.lo, hi = args.hi;
    XcdBarrier bar; bar.wv = (unsigned)wave; bar.bar = (unsigned*)(ctl + CW_BAR); bar.x = 0; bar.st = nullptr;
    if (!args.multi) bar = xcd_barrier_post_rank((unsigned*)(ctl + CW_BAR), MISC + 8, MISC + 12, (unsigned)wave);
#define IN(id) (lo <= (id) && (id) < hi)
    unsigned long long pr_acc = 0ull, pr_t0 = 0ull, pr_dummy = 0ull;
#define PRE(sitecls) ((PROBE_CLASS == 21 || PROBE_CLASS == (sitecls)) ? pr_acc : pr_dummy)
#define PSTART(cls) do { if (PROBE_CLASS == (cls)) pr_t0 = wall_clock64(); } while (0)
#define PEND(cls) do { if (PROBE_CLASS == (cls)) pr_acc += wall_clock64() - pr_t0; } while (0)
    int vc = (int)blockIdx.x, xmode = 0, bsel = 0;
#define SEAML(id) do { if (hi > (id) + 1) { PSTART(10); XcdBarrier bl_ = bar; asm volatile("" : "+s"(bl_.bar)); if (xmode) xcd_local_barrier(bl_, MISC + 12, MISC + 14); else xcd_barrier(bl_); PEND(10); } } while (0)
#define SEAM(id) do { if (hi > (id) + 1) { PSTART(10); XcdBarrier bl_ = bar; asm volatile("" : "+s"(bl_.bar)); if (xmode) xcd_pair_barrier(bl_, MISC + 12, MISC + 15); else xcd_barrier(bl_); PEND(10); } } while (0)

    if (IN(PH_PRO)) {
        PSTART(0);
        LAS float* scr = (LAS float*)(L + RING_OFF + wave * 16384);
        constexpr int I_IN = 16 * 96, I_OUT = 16 * 32, I_UP = 16 * 128, I_DN = 64 * 32, I_LAYER = I_IN + I_OUT + I_UP + I_DN;
        auto decode = [&](int it) -> P0Item {
            const int Ly = it / I_LAYER, j = Ly >> 1; int r = it % I_LAYER; const float* g = norm_g + (size_t)Ly * 4 * D;
            bf16* wl = (bf16*)(ws + WS_W + (size_t)Ly * W_LAYER); P0Item I;
            if (r < I_IN) { const int kb_ = r / 96, n0 = (r % 96) * 32;
                if (!(Ly & 1)) I = P0Item{w_in_m + (size_t)j * D * MIN_COLS, g, wl + W_IN / 2, MIN_COLS, n0, kb_ * 64, D, n0, (n0 >= 512 && n0 < 1024) ? 0.08838834764831845f : 1.0f};
                else { int src; if (n0 < 2048) { const int pn = n0 >> 8, within = n0 & 255; src = within < 128 ? 1024 + 128 * pn + within : 2048 + 128 * pn + (within - 128); } else src = n0 - 2048;
                    I = P0Item{w_in_c + (size_t)j * D * 3072, g, wl + W_IN / 2, 3072, src, kb_ * 64, D, n0, 1.0f}; }
                return I; } r -= I_IN;
            if (r < I_OUT) { const int kb_ = r / 32, nb = r % 32; return P0Item{((Ly & 1) ? w_out_c : w_out_m) + (size_t)j * D * D, nullptr, wl + W_OUT / 2, D, nb * 32, kb_ * 64, D, nb * 32, 1.0f}; } r -= I_OUT;
            if (r < I_UP) { const int kb_ = r / 128, nb = r % 128; return P0Item{w_up + (size_t)Ly * D * FF, g + 2 * D, wl + W_UP / 2, FF, nb * 32, kb_ * 64, D, nb * 32, 1.0f}; } r -= I_UP;
            { const int kb_ = r / 32, nb = r % 32; return P0Item{w_dn + (size_t)Ly * FF * D, nullptr, wl + W_DN / 2, D, nb * 32, kb_ * 64, FF, nb * 32, 1.0f}; }
        };
        static_assert((DEPTH * I_LAYER) % 2 == 0 && I_IN % 2 == 0, "items are taken in pairs");
        constexpr int P1_PAIRS = (DEPTH * I_LAYER - I_IN) / 2;
        PSTART(12);
        for (int it = gw; it < I_IN / 2; it += ngw) {
            const P0Item Ia = decode(it), Ib = decode(it + I_IN / 2); float va_[32], vb_[32];
            p0_load(Ia, va_, lane); p0_load(Ib, vb_, lane);
            p0_finish(Ia, va_, scr, lane); p0_finish(Ib, vb_, scr, lane);
        }
        PEND(12);
        for (int idx = gtid; idx < 2 * 16 * D; idx += gthreads) { const int jl = idx >> 14, jg = (idx >> 10) & 15, k = idx & 1023;
            wgT[idx] = (jg < 8) ? (bf16)f2bf(w_in_m[((size_t)jl * D + k) * MIN_COLS + 3072 + jg] * norm_g[(size_t)(2 * jl) * 4 * D + k]) : (bf16)0; }
        for (int r0 = gw * 4; r0 < M; r0 += ngw * 4) {
            f32x4 v[4][4];
#pragma unroll
            for (int i = 0; i < 4; ++i)
#pragma unroll
                for (int j = 0; j < 4; ++j) v[i][j] = *(const GAS f32x4*)(x_in + (size_t)(r0 + i) * D + 4 * lane + 256 * j);
            float s2r[4];
#pragma unroll
            for (int i = 0; i < 4; ++i) { bf16* orow = xb + (size_t)(r0 + i) * D; float s2 = 0.f;
#pragma unroll
                for (int j = 0; j < 4; ++j) { const unsigned p0 = pk2(v[i][j][0], v[i][j][1]), p1 = pk2(v[i][j][2], v[i][j][3]);
                    const float q0 = __uint_as_float(p0 << 16), q1 = __uint_as_float(p0 & 0xffff0000u), q2 = __uint_as_float(p1 << 16), q3 = __uint_as_float(p1 & 0xffff0000u);
                    s2 += (q0 * q0 + q1 * q1) + (q2 * q2 + q3 * q3); *(GAS unsigned long long*)(orow + 4 * lane + 256 * j) = (unsigned long long)p0 | ((unsigned long long)p1 << 32); }
                s2r[i] = wave_sum(s2); }
            if (lane < 4) { const float val = lane == 0 ? s2r[0] : lane == 1 ? s2r[1] : lane == 2 ? s2r[2] : s2r[3];
                ssq[r0 + lane] = val; ssq[M + r0 + lane] = 0.f; ssq[2 * M + r0 + lane] = 0.f; ssq[3 * M + r0 + lane] = 0.f; }
        }
        for (int idx = gtid; idx < 4 * M; idx += gthreads) ((unsigned long long*)(ws + WS_XG))[idx] = 0ull;
        PEND(0);
        SEAM(PH_PRO);
        if (!MK_MULTI) {
            if (TIDN == 0) { unsigned ok = (G == 256) ? 1u : 0u; const unsigned* bw = (const unsigned*)(ctl + CW_BAR);
#pragma unroll
                for (unsigned jx = 0; jx < 16; ++jx) { const unsigned cx = xb_ld((unsigned*)&bw[XB_XCNT(jx)]); ok &= (cx == (jx < 8u ? 32u : 0u)) ? 1u : 0u; }
                MISC[13] = ok; }
            __syncthreads();
            xmode = __builtin_amdgcn_readfirstlane((int)MISC[13]);
            if (xmode) { vc = __builtin_amdgcn_readfirstlane((int)MISC[12]) * 8 + (int)bar.x; bsel = (int)(bar.x >> 1); }
        }
        { int q0 = gw, q1 = P1_PAIRS, qs = ngw;
            if (xmode) { const int p = bsel; q0 = P1_PAIRS / 6 * (p * (p - 1) / 2) + (((vc & 1) * 32 + (vc >> 3)) * NWAVES + wave); q1 = (p == 3) ? P1_PAIRS : P1_PAIRS / 6 * (p * (p + 1) / 2); qs = 64 * NWAVES; if (p == 0) q1 = 0; }
            PSTART(12);
            for (int q = q0; q < q1; q += qs) {
                const P0Item Ia = decode(I_IN + q), Ib = decode(I_IN + P1_PAIRS + q); float va_[32], vb_[32];
                p0_load(Ia, va_, lane); p0_load(Ib, vb_, lane);
                p0_finish(Ia, va_, scr, lane); p0_finish(Ib, vb_, scr, lane);
            }
            PEND(12);
            if (xmode) { if (bsel != 0) { asm volatile("s_waitcnt vmcnt(0)" ::: "memory"); __syncthreads();
                    if (TIDN == 0) { __builtin_amdgcn_fence(__ATOMIC_RELEASE, "agent"); asm volatile("s_waitcnt vmcnt(0)" ::: "memory"); (void)xb_add((unsigned*)(ctl + CW_BAR) + XB_WDONE, 1u); } } }
            else SEAM(PH_PRO);
        }
    }
#define WREADY() do { if (xmode) { if (wave == 0) { unsigned* bw_ = (unsigned*)(ctl + CW_BAR); XB_SPIN(xb_ld(&bw_[XB_WDONE]) < 192u, bw_); __builtin_amdgcn_fence(__ATOMIC_ACQUIRE, "agent"); asm volatile("s_waitcnt vmcnt(0)" ::: "memory"); } \
        __syncthreads(); } } while (0)

    for (int hl = 0; hl < 2 * DEPTH; ++hl) {
        const int Ly = hl >> 1, j = Ly >> 1, pid = 1 + hl * PH_PER_HL;
        const float* g = norm_g + (size_t)Ly * 4 * D;
        const bf16* wl = (const bf16*)(ws + WS_W + (size_t)Ly * W_LAYER);
        const bf16* nA; const bf16* nB; int nK; const float* ngain;
        if (!(hl & 1)) {
            if (!(Ly & 1)) {
                if (IN(pid + 0)) {
                    PSTART(1); PSTART(11);
                    #if NAIVE_GATES
                    gates_naive(xb, w_in_m + (size_t)j * D * MIN_COLS, g, b_gates + j * 8, ssq, igp, lfp, blockIdx.x * NT + TIDN, gthreads);
#else
                    gates_fast(xb, wgT + (size_t)j * 16 * D, b_gates + j * 8, ssq, igp, lfp, (vc & 7) * 256 + (vc >> 3) * 8 + wave, M / 16, TIDN & 63);
#endif
                    PEND(11);
                    pg8::Gemm gm{xb, wl + W_IN / 2, M, 3072, D}; pg8::StaticOrder S; S.init(M, 3072, G, vc);
                    pg8::EpiMlstmIn E{qb, kb, vb, ob, ssq, (LAS float*)(L + LDSCTL_OFF + 14336)};
                    pg8::gemm_phase<pg8::EpiMlstmIn, pg8::StaticOrder, true, true>(L + RING_OFF, gm, S, E, TIDN, pr_acc, PRE(23));
                    if (hl == 0) WREADY();
                    PEND(1);
                    SEAML(pid + 0);
                }
                #if NAIVE_B1
                if (IN(pid + 1)) { b1_naive(kb, vb, igp, lfp, kvT, nloc, blast, mloc, (LAS float*)(L + RING_OFF), TIDN, G); SEAM(pid + 1); }
#else
                if (IN(pid + 1)) { PSTART(2); b1_fast(kb, vb, igp, lfp, kvT, nloc, blast, mloc, L + RING_OFF, TIDN, vc); PEND(2); SEAM(pid + 1); }
#endif
                #if NAIVE_B2
                if (IN(pid + 2)) { b2_naive(kvT, CT, nloc, nprev, blast, mloc, mprev, blockIdx.x * NT + TIDN, gthreads); SEAM(pid + 2); }
#else
                if (IN(pid + 2)) { PSTART(3); b2_fast(kvT, CT, nloc, NPB, blast, mloc, mprev, L + RING_OFF, TIDN, xmode ? 64 * ((vc & 7) >> 1) + 32 * (vc & 1) + (vc >> 3) : vc, G); PEND(3); SEAM(pid + 2); }
#endif
                #if NAIVE_B3
                if (IN(pid + 3)) { b3_naive(qb, kb, vb, ob, CT, nprev, mprev, igp, lfp, g_hnorm + (size_t)j * D, (LAS float*)(L + RING_OFF), TIDN, G); SEAM(pid + 3); }
#else
                if (IN(pid + 3)) { PSTART(4); b3_fast(qb, kb, vb, ob, CT, NPB, mprev, igp, lfp, g_hnorm + (size_t)j * D, L + RING_OFF, TIDN, vc); PEND(4); SEAML(pid + 3); }
#endif
                nA = ob;
            } else {
                if (IN(pid + 0)) {
                    PSTART(5);
                    pg8::Gemm gm{xb, wl + W_IN / 2, M, 3072, D}; pg8::StaticOrder S; S.init(M, 3072, G, vc);
                    pg8::EpiConvIn E{ub, bgb, ssq, (LAS float*)(L + LDSCTL_OFF + 14336)};
                    pg8::gemm_phase<pg8::EpiConvIn, pg8::StaticOrder, true, true>(L + RING_OFF, gm, S, E, TIDN, pr_acc, PRE(23));
                    PEND(5);
                    SEAM(pid + 0);
                }
                if (IN(pid + 1)) { PSTART(6); conv_phase(bgb, ub, w_conv + (size_t)j * 3 * D, (vc & 7) * 131072, (vc >> 3) * NT + TIDN); PEND(6); SEAML(pid + 1); }
                nA = bgb;
            }
            nB = wl + W_OUT / 2; nK = D; ngain = g + D;
        } else {
            if (IN(pid + 0)) {
                PSTART(8);
                pg8::Gemm gm{xb, wl + W_UP / 2, M, FF, D}; pg8::StaticOrder S; S.init(M, FF, G, vc);
                pg8::EpiUp E{hid, ssq, (LAS float*)(L + LDSCTL_OFF + 14336)};
                pg8::gemm_phase<pg8::EpiUp, pg8::StaticOrder, true, true>(L + RING_OFF, gm, S, E, TIDN, pr_acc, PRE(24));
                PEND(8);
                SEAML(pid + 0);
            }
            nA = hid; nB = wl + W_DN / 2; nK = FF; ngain = g + 3 * D;
        }
        if (IN(pid + 4)) {
            const int last = (hl == 2 * DEPTH - 1) ? 1 : 0;
            if (hl & 1) PSTART(9); else PSTART(7);
            unsigned* xchp = (unsigned*)(ws + ((hl & 1) ? WS_XCH2 : WS_XCH));
            { pg8::Gemm gm{nA, nB, M, D, nK}; pg8::StaticOrder S; S.init(M, D, G, vc, hl & 1);
              pg8::EpiPost E{xb, args.out, ngain, ssq, (unsigned long long*)(ws + WS_XG), (unsigned)(hl + 1), xmode, (unsigned*)(ctl + CW_TMO), L + LDSCTL_OFF + 1024, last};
              pg8::gemm_phase<pg8::EpiPost, pg8::StaticOrder, true, true>(L + RING_OFF, gm, S, E, TIDN, pr_acc, PRE(22)); }
            if (hl & 1) PEND(9); else PEND(7);
            SEAML(pid + 4);
        }
    }
    if (PROBE_CLASS >= 30 && PROBE_CLASS <= 33) pr_acc += ((volatile LAS unsigned*)(L + LDSCTL_OFF + 1024 + 12288))[8 + (PROBE_CLASS - 30)];
    if (PROBE_CLASS >= 0 && blockIdx.x == 0 && TIDN == 0) { const unsigned long long t0 = wall_clock64(); while (wall_clock64() - t0 < (unsigned long long)PROBE_GAIN * pr_acc) __builtin_amdgcn_s_sleep(10); }
#undef IN
#undef SEAM
}

extern "C" void kernel_launch(void* const* d_in, const int* in_sizes, int n_in, void* d_out, int out_size, void* d_ws, size_t ws_size, hipStream_t stream) {
    static int grid = 0;
    if (grid == 0) {
        if (n_in != 11 || in_sizes[0] != M * D || out_size != M * D || ws_size < WS_END) { fprintf(stderr, "kernel_launch: unexpected shapes: n_in %d in0 %d out %d ws %zu (need %zu)\n", n_in, n_in > 0 ? in_sizes[0] : -1, out_size, ws_size, (size_t)WS_END); grid = -1; return; }
        int dev = 0, cus = 0, per_cu = 0;
        if (hipGetDevice(&dev) != hipSuccess || hipDeviceGetAttribute(&cus, hipDeviceAttributeMultiprocessorCount, dev) != hipSuccess) { grid = -1; return; }
        if (hipFuncSetAttribute((const void*)mk_fwd, hipFuncAttributeMaxDynamicSharedMemorySize, LDS_BYTES) != hipSuccess) { fprintf(stderr, "kernel_launch: hipFuncSetAttribute failed\n"); grid = -1; return; }
        if (hipOccupancyMaxActiveBlocksPerMultiprocessor(&per_cu, (const void*)mk_fwd, NT, LDS_BYTES) != hipSuccess || per_cu < 1) fprintf(stderr, "kernel_launch: occupancy query reports %d\n", per_cu);
        (void)hipGetLastError();
        grid = cus;
        if (grid != 256) { fprintf(stderr, "kernel_launch: %d CUs; the fused post-norm epilogue needs exactly 256 workgroups; nothing launched\n", grid); grid = -1; return; }
    }
    if (grid < 0) return;
    if (hipMemsetAsync((char*)d_ws + WS_CTL, 0, CTL_ZERO_BYTES, stream) != hipSuccess) return;
    Args a{};
    for (int i = 0; i < 11; ++i) a.in[i] = (const float*)d_in[i];
    a.out = (float*)d_out; a.ws = (unsigned char*)d_ws; a.pad = 0;
#if MK_MULTI
    a.multi = 1;
    int ids[64]; int n = 0; ids[n++] = PH_PRO;
    for (int hl = 0; hl < 2 * DEPTH; ++hl) { const int Ly = hl >> 1, pid = 1 + hl * PH_PER_HL;
        if (!(hl & 1)) { ids[n++] = pid; ids[n++] = pid + 1; if (!(Ly & 1)) { ids[n++] = pid + 2; ids[n++] = pid + 3; } } else ids[n++] = pid;
        ids[n++] = pid + 4; }
    for (int i = 0; i < n; ++i) { a.lo = ids[i]; a.hi = ids[i] + 1; hipLaunchKernelGGL(mk_fwd, dim3(grid), dim3(NT), LDS_BYTES, stream, a); }
#else
    a.multi = 0; a.lo = 0; a.hi = PH_END;
    hipLaunchKernelGGL(mk_fwd, dim3(grid), dim3(NT), LDS_BYTES, stream, a);
#endif
    const hipError_t le = hipPeekAtLastError();
    if (le != hipSuccess) fprintf(stderr, "kernel_launch: launch failed: %s\n", hipGetErrorName(le));
}
```
